# Optimizing an MI355X kernel written in HIP

```python
import math
import jax, jax.numpy as jnp
from jax import lax
import numpy as np

D_MODEL = 1024
BATCH = 2
SEQ = 16384
DEPTH = 2
DEC_BATCH = 16
DEC_SEQ = 64
PAST_LEN = 2048

CHUNK = 64
N_MEM = 256
CONV_CH = D_MODEL
CONV_WIDTH = 31
N_Q = 16
N_KV = 2
HEAD_DIM = 64
G = N_Q // N_KV
WINDOW = 128
WIN_CHUNKS = WINDOW // CHUNK
ROPE_THETA = 10000.0
N_XH = 4
XHEAD_DIM = 128
X_WIDTH = N_XH * XHEAD_DIM
N_CONV_LAYERS = (DEPTH + 1) // 2
N_ATTN_LAYERS = DEPTH // 2
ATTN_Q = N_Q * HEAD_DIM
ATTN_KV = N_KV * HEAD_DIM
CONV_IN = 3 * CONV_CH + 2 * X_WIDTH
ATTN_IN = 2 * ATTN_Q + 2 * ATTN_KV + 2 * X_WIDTH
BRANCH_W = CONV_CH + X_WIDTH
RMS_EPS = 1e-6
LN_EPS = 1e-5

kernel_name = 'streaming_conv_swa_mem_hybrid'


def rms_norm(x, g):
    xf = x.astype(jnp.float32)
    y = xf * lax.rsqrt(jnp.mean(xf * xf, axis=-1, keepdims=True) + RMS_EPS)
    return (y * g.astype(jnp.float32)).astype(x.dtype)


def layer_norm(x, g, b):
    xf = x.astype(jnp.float32)
    mu = jnp.mean(xf, axis=-1, keepdims=True)
    xc = xf - mu
    y = xc * lax.rsqrt(jnp.mean(xc * xc, axis=-1, keepdims=True) + LN_EPS)
    return (y * g.astype(jnp.float32) + b.astype(jnp.float32)).astype(x.dtype)


def rope(x, pos):
    half = HEAD_DIM // 2
    inv = ROPE_THETA ** (-jnp.arange(half, dtype=jnp.float32) / half)
    ang = pos.astype(jnp.float32)[:, None] * inv[None, :]
    cos = jnp.cos(ang)[:, None, :]
    sin = jnp.sin(ang)[:, None, :]
    xf = x.astype(jnp.float32)
    x1, x2 = xf[..., :half], xf[..., half:]
    return jnp.concatenate([x1 * cos - x2 * sin, x2 * cos + x1 * sin], axis=-1).astype(x.dtype)


def sink_softmax(s, sink):
    sink = jnp.broadcast_to(sink.astype(jnp.float32), s.shape[:-1] + (1,))
    return jax.nn.softmax(jnp.concatenate([s, sink], axis=-1), axis=-1)[..., :-1]


def swa_banded(q, k, v, sinks):
    B, S = q.shape[:2]
    nc = S // CHUNK
    pad = WIN_CHUNKS * CHUNK
    L = (WIN_CHUNKS + 1) * CHUNK
    kp = jnp.pad(k, ((0, 0), (pad, 0), (0, 0), (0, 0))).reshape(B, nc + WIN_CHUNKS, CHUNK, N_KV, HEAD_DIM)
    vp = jnp.pad(v, ((0, 0), (pad, 0), (0, 0), (0, 0))).reshape(B, nc + WIN_CHUNKS, CHUNK, N_KV, HEAD_DIM)
    kb = jnp.concatenate([kp[:, j:j + nc] for j in range(WIN_CHUNKS + 1)], axis=2)
    vb = jnp.concatenate([vp[:, j:j + nc] for j in range(WIN_CHUNKS + 1)], axis=2)
    qb = q.reshape(B, nc, CHUNK, N_KV, G, HEAD_DIM)
    s = jnp.einsum('bcqkgd,bcjkd->bckgqj', qb, kb).astype(jnp.float32) * (1.0 / math.sqrt(HEAD_DIM))
    key_chunk = jnp.arange(nc)[:, None] - WIN_CHUNKS + jnp.arange(L)[None, :] // CHUNK
    valid = (key_chunk >= 0)[None, :, None, None, None, :]
    s = jnp.where(valid, s, -jnp.inf)
    p = sink_softmax(s, sinks.reshape(1, 1, N_KV, G, 1, 1))
    o = jnp.einsum('bckgqj,bcjkd->bcqkgd', p.astype(vb.dtype), vb)
    return o.reshape(B, S, ATTN_Q)


def swa_with_past(q, kk, vv, sinks):
    B, T = q.shape[:2]
    qb = q.reshape(B, T, N_KV, G, HEAD_DIM)
    s = jnp.einsum('btkgd,bjkd->bkgtj', qb, kk).astype(jnp.float32) * (1.0 / math.sqrt(HEAD_DIM))
    p = sink_softmax(s, sinks.reshape(1, N_KV, G, 1, 1))
    o = jnp.einsum('bkgtj,bjkd->btkgd', p.astype(vv.dtype), vv)
    return o.reshape(B, T, ATTN_Q)


def depthwise_causal(u_ext, w, b):
    out = lax.conv_general_dilated(u_ext, w[:, None, :].astype(u_ext.dtype), window_strides=(1,),
                                   padding='VALID', dimension_numbers=('NWC', 'WIO', 'NWC'),
                                   feature_group_count=CONV_CH)
    return out + b.astype(out.dtype)


def mem_cross_attn(q, mk, mv):
    B, T = q.shape[:2]
    s = jnp.einsum('bthd,bmhd->bhtm', q, mk).astype(jnp.float32) * (1.0 / math.sqrt(XHEAD_DIM))
    p = jax.nn.softmax(s, axis=-1)
    o = jnp.einsum('bhtm,bmhd->bthd', p.astype(mv.dtype), mv)
    return o.reshape(B, T, X_WIDTH)


def trunk(x, pos, mem_k, mem_v, conv_hist, swa_k_hist, swa_v_hist,
          norm_g, w_in_conv, conv_w, conv_b, ln_g, ln_b, w_in_attn, sinks, w_out, final_g):
    B, T = x.shape[:2]
    new_conv, new_k, new_v = [], [], []
    for i in range(DEPTH):
        j = i // 2
        h = rms_norm(x, norm_g[i])
        if i % 2 == 0:
            p = h @ w_in_conv[j]
            a, bg, z, xq, xz = jnp.split(p, [CONV_CH, 2 * CONV_CH, 3 * CONV_CH, 3 * CONV_CH + X_WIDTH], axis=-1)
            u = a * jax.nn.sigmoid(bg)
            hist = jnp.zeros((B, CONV_WIDTH - 1, CONV_CH), u.dtype) if conv_hist is None else conv_hist[j].astype(u.dtype)
            u_ext = jnp.concatenate([hist, u], axis=1)
            c = depthwise_causal(u_ext, conv_w[j], conv_b[j])
            mix = jax.nn.silu(layer_norm(c, ln_g[j], ln_b[j])) * jax.nn.silu(z)
            new_conv.append(u_ext[:, -(CONV_WIDTH - 1):])
        else:
            p = h @ w_in_attn[j]
            q, k, v, z, xq, xz = jnp.split(
                p, [ATTN_Q, ATTN_Q + ATTN_KV, ATTN_Q + 2 * ATTN_KV, 2 * ATTN_Q + 2 * ATTN_KV,
                    2 * ATTN_Q + 2 * ATTN_KV + X_WIDTH], axis=-1)
            q = rope(q.reshape(B, T, N_Q, HEAD_DIM), pos)
            k = rope(k.reshape(B, T, N_KV, HEAD_DIM), pos)
            v = v.reshape(B, T, N_KV, HEAD_DIM)
            if swa_k_hist is None:
                o = swa_banded(q, k, v, sinks[j])
                new_k.append(k[:, -WINDOW:])
                new_v.append(v[:, -WINDOW:])
            else:
                kk = jnp.concatenate([swa_k_hist[j].astype(k.dtype), k], axis=1)
                vv = jnp.concatenate([swa_v_hist[j].astype(v.dtype), v], axis=1)
                o = swa_with_past(q, kk, vv, sinks[j])
                new_k.append(kk[:, -WINDOW:])
                new_v.append(vv[:, -WINDOW:])
            mix = o * jax.nn.silu(z)
        xo = mem_cross_attn(xq.reshape(B, T, N_XH, XHEAD_DIM), mem_k[i].astype(xq.dtype),
                            mem_v[i].astype(xq.dtype)) * jax.nn.silu(xz)
        x = x + jnp.concatenate([mix, xo], axis=-1) @ w_out[i]
    return rms_norm(x, final_g), jnp.stack(new_conv), jnp.stack(new_k), jnp.stack(new_v)


def setup_inputs(seed: int = 0) -> dict:
    key = jax.random.key(seed)
    ks = jax.random.split(key, 20)
    f32 = jnp.float32

    def nrm(k, shape, s):
        return jax.random.normal(k, shape, f32) * s

    return {
        'x_prompt': nrm(ks[0], (BATCH, SEQ, D_MODEL), 1.0),
        'x_sample': nrm(ks[1], (DEC_BATCH, DEC_SEQ, D_MODEL), 1.0),
        'state_conv': nrm(ks[2], (N_CONV_LAYERS, DEC_BATCH, CONV_WIDTH - 1, CONV_CH), 0.5),
        'cache_swa_k': nrm(ks[3], (N_ATTN_LAYERS, DEC_BATCH, WINDOW, N_KV, HEAD_DIM), 1.0),
        'cache_swa_v': nrm(ks[4], (N_ATTN_LAYERS, DEC_BATCH, WINDOW, N_KV, HEAD_DIM), 1.0),
        'cache_mem_k': nrm(ks[5], (DEPTH, DEC_BATCH, N_MEM, N_XH, XHEAD_DIM), 1.0),
        'cache_mem_v': nrm(ks[6], (DEPTH, DEC_BATCH, N_MEM, N_XH, XHEAD_DIM), 1.0),
        'mem_prompt': nrm(ks[7], (BATCH, N_MEM, D_MODEL), 1.0),
        'norm_g': 1.0 + nrm(ks[8], (DEPTH, D_MODEL), 0.02),
        'w_in_conv': nrm(ks[9], (N_CONV_LAYERS, D_MODEL, CONV_IN), D_MODEL ** -0.5),
        'conv_w': nrm(ks[10], (N_CONV_LAYERS, CONV_WIDTH, CONV_CH), CONV_WIDTH ** -0.5),
        'conv_b': nrm(ks[11], (N_CONV_LAYERS, CONV_CH), 0.01),
        'ln_g': 1.0 + nrm(ks[12], (N_CONV_LAYERS, CONV_CH), 0.02),
        'ln_b': nrm(ks[13], (N_CONV_LAYERS, CONV_CH), 0.01),
        'w_in_attn': nrm(ks[14], (N_ATTN_LAYERS, D_MODEL, ATTN_IN), D_MODEL ** -0.5),
        'sinks': nrm(ks[15], (N_ATTN_LAYERS, N_Q), 1.0),
        'w_mem_kv': nrm(ks[16], (DEPTH, D_MODEL, 2 * X_WIDTH), D_MODEL ** -0.5),
        'w_out': nrm(ks[17], (DEPTH, BRANCH_W, D_MODEL), BRANCH_W ** -0.5),
        'final_g': 1.0 + nrm(ks[18], (D_MODEL,), 0.02),
    }


def reference(x_prompt, x_sample, state_conv, cache_swa_k, cache_swa_v, cache_mem_k, cache_mem_v,
              mem_prompt, norm_g, w_in_conv, conv_w, conv_b, ln_g, ln_b, w_in_attn, sinks,
              w_mem_kv, w_out, final_g):
    kv = jnp.einsum('bmd,lde->lbme', mem_prompt, w_mem_kv)
    mem_k_p = kv[..., :X_WIDTH].reshape(DEPTH, BATCH, N_MEM, N_XH, XHEAD_DIM)
    mem_v_p = kv[..., X_WIDTH:].reshape(DEPTH, BATCH, N_MEM, N_XH, XHEAD_DIM)

    pos_p = jnp.arange(x_prompt.shape[1], dtype=jnp.int32)
    y_prompt, conv_p, k_p, v_p = trunk(x_prompt, pos_p, mem_k_p, mem_v_p, None, None, None,
                                       norm_g, w_in_conv, conv_w, conv_b, ln_g, ln_b, w_in_attn,
                                       sinks, w_out, final_g)

    pos_s = PAST_LEN + jnp.arange(x_sample.shape[1], dtype=jnp.int32)
    y_sample, conv_s, k_s, v_s = trunk(x_sample, pos_s, cache_mem_k, cache_mem_v, state_conv,
                                       cache_swa_k, cache_swa_v,
                                       norm_g, w_in_conv, conv_w, conv_b, ln_g, ln_b, w_in_attn,
                                       sinks, w_out, final_g)
    return (y_prompt, y_sample, conv_p, conv_s, k_p, v_p, k_s, v_s, mem_k_p, mem_v_p)
```

```cpp
#include <hip/hip_runtime.h>
#include <hip/hip_cooperative_groups.h>
#include <cstdio>
#include <cstdint>
namespace cg = cooperative_groups;
namespace pg8 {
#define PG8_LAS __attribute__((address_space(3)))
typedef unsigned short bf16_t;
typedef short bf16x8 __attribute__((ext_vector_type(8)));
typedef float f32x4 __attribute__((ext_vector_type(4)));
typedef unsigned u32x4 __attribute__((ext_vector_type(4)));
constexpr int BM = 256, BK = 64, HALF = 128, HTB = HALF * BK * 2  , STAGE_BYTES = 8 * HTB, NXCD = 8, WGM = 8;

__host__ __device__ __forceinline__ int lds_byte(int r, int c) { const int st = (r >> 4) * 2 + (c >> 5), rr = r & 15, cc = c & 31, ob = rr * 64 + cc * 2; return st * 1024 + (ob ^ (((ob >> 9) & 1) << 5)); }
__host__ __device__ __forceinline__ void stage_rc(int b, int& R, int& C) { const int st = b / 1024, sb = b % 1024, swz = sb ^ (((sb >> 9) & 1) << 5); R = (st >> 1) * 16 + swz / 64; C = (st & 1) * 32 + (swz % 64) / 2; }
__host__ __device__ __forceinline__ int perm32(int rho) { const int n = rho >> 4, i = rho & 15; return 8 * (i >> 2) + 4 * n + (i & 3); }

struct Unit { int pm, pn, ko, ix; };
struct Gemm { const bf16_t* A; const bf16_t* Bt; int M, N, K, ld; };

struct StaticOrder {
    int nM, nN, nwg, G, c;
    __host__ __device__ void init(int M, int N, int G_, int c_) { nM = M / BM; nN = N / BM; nwg = nM * nN; G = G_; c = c_; }
    __host__ __device__ bool next(int i, Unit& u) const {
        const long L = (long)i * G + c; if (L >= nwg) return false;
        int wgid = (int)L; { const int q = nwg / NXCD, r = nwg % NXCD, xcd = wgid % NXCD, off = wgid / NXCD; wgid = (xcd < r ? xcd * (q + 1) : r * (q + 1) + (xcd - r) * q) + off; }
        const int nig = WGM * nN, gid = wgid / nig, fm = gid * WGM, gsz = (nM - fm) < WGM ? (nM - fm) : WGM;
        u.pm = fm + ((wgid % nig) % gsz); u.pn = (wgid % nig) / gsz; u.ko = 0; u.ix = i; return true;
    }
    __device__ __forceinline__ void a_ready(const Unit&) const {}
    __device__ __forceinline__ void done(const Unit&) const {}
};

__device__ __forceinline__ unsigned cvt_pk_bf16(float lo, float hi) { unsigned r; asm volatile("v_cvt_pk_bf16_f32 %0, %1, %2" : "=v"(r) : "v"(lo), "v"(hi)); return r; }
typedef float f32x2 __attribute__((ext_vector_type(2)));
template <class Epi, class Sched, bool ALIGN_EPI = false, bool SP2 = false>
__device__ __forceinline__ void gemm_phase(PG8_LAS unsigned char* lds, const Gemm g, const Sched& S, const Epi& E) {
    const int tid = threadIdx.x, wid = __builtin_amdgcn_readfirstlane(tid >> 6), lane = tid & 63, wr = wid >> 2, wc = wid & 3, fr = lane & 15, fq = lane >> 4;
    const int K = g.ld, nt = g.K / BK;
    unsigned voffA[2], voffB[2];
#pragma unroll
    for (int i = 0; i < 2; ++i) { int R, C; stage_rc(tid * 16 + i * 8192, R, C); const int Rb = Epi::PERM ? ((R & ~31) + perm32(R & 31)) : R;
        voffA[i] = (unsigned)(R * K + C) * 2u; voffB[i] = (unsigned)(Rb * K + C) * 2u; }
    const size_t kstep = (size_t)(BK * 2);
    const size_t hstep = (size_t)HALF * K * 2;
    const size_t tstep = 2 * hstep;
    const unsigned ldsw = (unsigned)wid * 1024u;
    const int aoff = lds_byte(wr * 64 + fr, fq * 8), boff = lds_byte(wc * 32 + fr, fq * 8);
#define PG8_SA(b, h) (((b) * 2 + (h)) * HTB)
#define PG8_SB(b, h) ((4 + (b) * 2 + (h)) * HTB)
#define PG8_STAGE(bufoff, gbase, voff) do { _Pragma("unroll") for (int _i = 0; _i < 2; ++_i) \
        __builtin_amdgcn_global_load_lds((const unsigned*)((const char*)(gbase) + (voff)[_i]), (PG8_LAS unsigned*)(lds + (bufoff) + ldsw + _i * 8192), 16, 0, 0); } while (0)
#define PG8_LDA(dst, b, h) do { _Pragma("unroll") for (int m = 0; m < 4; ++m) _Pragma("unroll") for (int k = 0; k < 2; ++k) dst[m][k] = *(const PG8_LAS bf16x8*)(lds + PG8_SA(b, h) + aoff + m * 2048 + k * 1024); } while (0)
#define PG8_LDB(dst, b, h) do { _Pragma("unroll") for (int n = 0; n < 2; ++n) _Pragma("unroll") for (int k = 0; k < 2; ++k) dst[n][k] = *(const PG8_LAS bf16x8*)(lds + PG8_SB(b, h) + boff + n * 2048 + k * 1024); } while (0)
#define PG8_MMA(ai, bj, At, Bt) do { __builtin_amdgcn_s_setprio(1); _Pragma("unroll") for (int m = 0; m < 4; ++m) _Pragma("unroll") for (int n = 0; n < 2; ++n) _Pragma("unroll") for (int k = 0; k < 2; ++k) \
        acc[ai][bj][m][n] = __builtin_amdgcn_mfma_f32_16x16x32_bf16(Bt[n][k], At[m][k], acc[ai][bj][m][n], 0, 0, 0); __builtin_amdgcn_s_setprio(0); } while (0)
#define PG8_WAIT_V(n) asm volatile("s_waitcnt vmcnt(" #n ")" ::: "memory")
#define PG8_WAIT_L(n) asm volatile("s_waitcnt lgkmcnt(" #n ")" ::: "memory")
#define PG8_BAR __builtin_amdgcn_s_barrier()
#define PG8_SCHED __builtin_amdgcn_sched_barrier(0)
    Unit cur, nxt; int ui = 0;
    if (!S.next(0, cur)) return;
    f32x4 acc[2][2][4][2];
#pragma unroll
    for (int a = 0; a < 2; ++a)
#pragma unroll
        for (int b = 0; b < 2; ++b)
#pragma unroll
            for (int m = 0; m < 4; ++m)
#pragma unroll
                for (int n = 0; n < 2; ++n) acc[a][b][m][n] = (f32x4){0.f, 0.f, 0.f, 0.f};
    bf16x8 At[4][2], B0[2][2], B1[2][2];
    const char* cA = (const char*)g.A + (size_t)cur.pm * tstep + (size_t)cur.ko * 2; const char* cB = (const char*)g.Bt + (size_t)cur.pn * tstep + (size_t)cur.ko * 2;
    S.a_ready(cur);
    if constexpr (SP2) {
        PG8_STAGE(PG8_SB(0, 0), cB, voffB); PG8_STAGE(PG8_SB(0, 1), cB + hstep, voffB); PG8_STAGE(PG8_SA(0, 0), cA, voffA); PG8_STAGE(PG8_SA(0, 1), cA + hstep, voffA);
        if (wr == 1) PG8_BAR;
        PG8_WAIT_V(2); PG8_BAR;
        PG8_STAGE(PG8_SB(1, 0), cB + kstep, voffB); PG8_STAGE(PG8_SA(1, 0), cA + kstep, voffA); PG8_STAGE(PG8_SB(1, 1), cB + hstep + kstep, voffB);
        PG8_WAIT_V(6); PG8_BAR;
    } else {
        PG8_STAGE(PG8_SB(0, 0), cB, voffB); PG8_STAGE(PG8_SA(0, 0), cA, voffA); PG8_STAGE(PG8_SB(0, 1), cB + hstep, voffB); PG8_STAGE(PG8_SA(0, 1), cA + hstep, voffA);
        if (wr == 1) PG8_BAR;
        PG8_WAIT_V(4); PG8_BAR;
        PG8_STAGE(PG8_SB(1, 0), cB + kstep, voffB); PG8_STAGE(PG8_SA(1, 0), cA + kstep, voffA); PG8_STAGE(PG8_SB(1, 1), cB + hstep + kstep, voffB);
        PG8_WAIT_V(6); PG8_BAR;
    }
    for (;;) {
        const bool has_next = S.next(ui + 1, nxt);
        const char* nA = has_next ? (const char*)g.A + (size_t)nxt.pm * tstep + (size_t)nxt.ko * 2 : cA; const char* nB = has_next ? (const char*)g.Bt + (size_t)nxt.pn * tstep + (size_t)nxt.ko * 2 : cB;
#pragma unroll 1
        for (int t = 0; t < nt; t += 2) {
            const bool last = (t == nt - 2);
            const char* a1 = cA + (size_t)(t + 1) * kstep;
            const char* a2 = last ? nA : cA + (size_t)(t + 2) * kstep; const char* b2 = last ? nB : cB + (size_t)(t + 2) * kstep;
            const char* a3 = a2 + kstep; const char* b3 = b2 + kstep;
            if (last && has_next) S.a_ready(nxt);
            if constexpr (SP2) {
            PG8_LDB(B0, 0, 0); PG8_LDB(B1, 0, 1); PG8_SCHED; PG8_LDA(At, 0, 0); PG8_STAGE(PG8_SA(1, 1), a1 + hstep, voffA);
            PG8_WAIT_V(8); PG8_WAIT_L(0); PG8_BAR; PG8_MMA(0, 0, At, B0); PG8_MMA(0, 1, At, B1); PG8_BAR; PG8_SCHED;
            PG8_LDA(At, 0, 1); PG8_STAGE(PG8_SB(0, 0), b2, voffB); PG8_STAGE(PG8_SB(0, 1), b2 + hstep, voffB); PG8_STAGE(PG8_SA(0, 0), a2, voffA);
            PG8_WAIT_V(8); PG8_WAIT_L(0); PG8_BAR; PG8_MMA(1, 0, At, B0); PG8_MMA(1, 1, At, B1); PG8_BAR; PG8_SCHED;
            PG8_LDB(B0, 1, 0); PG8_LDB(B1, 1, 1); PG8_SCHED; PG8_LDA(At, 1, 0); PG8_STAGE(PG8_SA(0, 1), a2 + hstep, voffA);
            PG8_WAIT_V(8); PG8_WAIT_L(0); PG8_BAR; PG8_MMA(0, 0, At, B0); PG8_MMA(0, 1, At, B1); PG8_BAR; PG8_SCHED;
            PG8_LDA(At, 1, 1); PG8_STAGE(PG8_SB(1, 0), b3, voffB); PG8_STAGE(PG8_SB(1, 1), b3 + hstep, voffB); PG8_STAGE(PG8_SA(1, 0), a3, voffA);
            PG8_WAIT_V(8); PG8_WAIT_L(0); PG8_BAR; PG8_MMA(1, 0, At, B0); PG8_MMA(1, 1, At, B1); PG8_BAR; PG8_SCHED;
            } else {
            PG8_LDB(B0, 0, 0); PG8_SCHED; PG8_LDA(At, 0, 0); PG8_STAGE(PG8_SA(1, 1), a1 + hstep, voffA);
            PG8_WAIT_L(8); PG8_BAR; PG8_WAIT_L(0); PG8_MMA(0, 0, At, B0); PG8_BAR; PG8_SCHED;
            PG8_LDB(B1, 0, 1); PG8_STAGE(PG8_SB(0, 0), b2, voffB);
            PG8_BAR; PG8_WAIT_L(0); PG8_MMA(0, 1, At, B1); PG8_BAR;
            PG8_LDA(At, 0, 1); PG8_STAGE(PG8_SA(0, 0), a2, voffA);
            PG8_BAR; PG8_WAIT_L(0); PG8_MMA(1, 0, At, B0); PG8_BAR; PG8_SCHED;
            PG8_STAGE(PG8_SB(0, 1), b2 + hstep, voffB);
            PG8_WAIT_V(6); PG8_BAR; PG8_MMA(1, 1, At, B1); PG8_BAR;
            PG8_LDB(B0, 1, 0); PG8_SCHED; PG8_LDA(At, 1, 0); PG8_STAGE(PG8_SA(0, 1), a2 + hstep, voffA);
            PG8_WAIT_L(8); PG8_BAR; PG8_WAIT_L(0); PG8_MMA(0, 0, At, B0); PG8_BAR; PG8_SCHED;
            PG8_LDB(B1, 1, 1); PG8_STAGE(PG8_SB(1, 0), b3, voffB);
            PG8_BAR; PG8_WAIT_L(0); PG8_MMA(0, 1, At, B1); PG8_BAR;
            PG8_LDA(At, 1, 1); PG8_STAGE(PG8_SA(1, 0), a3, voffA);
            PG8_BAR; PG8_WAIT_L(0); PG8_MMA(1, 0, At, B0); PG8_BAR; PG8_SCHED;
            PG8_STAGE(PG8_SB(1, 1), b3 + hstep, voffB);
            PG8_WAIT_V(6); PG8_BAR; PG8_MMA(1, 1, At, B1); PG8_BAR;
            }
        }
        if constexpr (ALIGN_EPI) { if (wr == 0) PG8_BAR; }
        if constexpr (!Epi::AFTER_DRAIN) { E(acc, cur, wr, wc, fr, fq); S.done(cur); }
        if (!has_next) break;
#pragma unroll
        for (int a = 0; a < 2; ++a)
#pragma unroll
            for (int b = 0; b < 2; ++b)
#pragma unroll
                for (int m = 0; m < 4; ++m)
#pragma unroll
                    for (int n = 0; n < 2; ++n) acc[a][b][m][n] = (f32x4){0.f, 0.f, 0.f, 0.f};
        cur = nxt; cA = nA; cB = nB; ++ui;
        if constexpr (ALIGN_EPI) { if (wr == 1) PG8_BAR; }
    }
    PG8_WAIT_V(0);
    if constexpr (!ALIGN_EPI) { if (wr == 0) PG8_BAR; }
    PG8_BAR;
    if constexpr (Epi::AFTER_DRAIN) { E.fused(acc, cur, wr, wc, fr, fq, lds, wid, lane); S.done(cur); }
#undef PG8_SA
#undef PG8_SB
#undef PG8_STAGE
#undef PG8_LDA
#undef PG8_LDB
#undef PG8_MMA
#undef PG8_WAIT_V
#undef PG8_WAIT_L
#undef PG8_BAR
#undef PG8_SCHED
}
}


#define LAS __attribute__((address_space(3)))
#define DI __device__ __forceinline__
using pg8::bf16_t; using pg8::bf16x8; using pg8::f32x4; using pg8::u32x4;
typedef short s16x4 __attribute__((ext_vector_type(4)));
typedef float f32x16 __attribute__((ext_vector_type(16)));
typedef float f32x2 __attribute__((ext_vector_type(2)));
typedef unsigned u32x2 __attribute__((ext_vector_type(2)));
typedef __bf16 bf16x2_t __attribute__((ext_vector_type(2)));

constexpr int TP = 32768, TSMP = 1024, TT = TP + TSMP;
constexpr int DM = 1024;
constexpr int NTHR = 512;
constexpr float LOG2E = 1.4426950408889634f;
constexpr float QSCALE = 0.125f * LOG2E;
constexpr float XSCALE = 0.08838834764831845f * LOG2E;
constexpr size_t MiB = 1u << 20;
constexpr size_t WS_PART = 416 * MiB;
constexpr size_t WS_CTL = 31 * MiB, CTL_BYTES = 65536;
constexpr size_t WS_PS = 28 * MiB;
constexpr size_t WS_WC = 0, WS_WA = 8 * MiB, WS_WO = 15 * MiB, WS_WM = 21 * MiB, WS_MP = 25 * MiB, WS_MK = 26 * MiB, WS_MV = 27 * MiB;
constexpr size_t WS_H = 32 * MiB, WS_U = 98 * MiB, WS_Z = 164 * MiB, WS_XQ = 230 * MiB, WS_XZ = 263 * MiB, WS_A2 = 296 * MiB, WS_K = 395 * MiB, WS_V = 404 * MiB, WS_END = 432 * MiB;
constexpr size_t O_Y = 0, O_CONVP = 34603008, O_CONVS = 34664448, O_KP = 35155968, O_VP = 35188736, O_KS = 35221504, O_VS = 35483648, O_MKP = 35745792, O_MVP = 36270080, O_TOTAL = 36794368;
constexpr int LDS_BYTES = 147456;

struct Args {
    const float* in[19]; float* out; unsigned char* ws; int ph_lo, ph_hi;
};

DI unsigned pk2(float lo, float hi) { f32x2 v = {lo, hi}; bf16x2_t b = __builtin_convertvector(v, bf16x2_t); return __builtin_bit_cast(unsigned, b); }
DI float bflo(unsigned u) { return __uint_as_float(u << 16); }
DI float bfhi(unsigned u) { return __uint_as_float(u & 0xffff0000u); }
DI float sigmoidf_(float x) { return __builtin_amdgcn_rcpf(1.0f + __expf(-x)); }
DI float siluf_(float x) { return x * sigmoidf_(x); }
DI u32x4 pack8(f32x4 a, f32x4 b) { u32x4 w; w.x = pk2(a[0], a[1]); w.y = pk2(a[2], a[3]); w.z = pk2(b[0], b[1]); w.w = pk2(b[2], b[3]); return w; }
DI u32x4 pack8f(const float* s) { f32x4 a = *(const f32x4*)s, b = *(const f32x4*)(s + 4); return pack8(a, b); }
DI float wave_sum(float v) {
#pragma unroll
    for (int o = 1; o < 64; o <<= 1) v += __shfl_xor(v, o);
    return v;
}

#define ROWLOOP _Pragma("unroll") for (int ai = 0; ai < 2; ++ai) _Pragma("unroll") for (int m = 0; m < 4; ++m)
#define ROWDEF const int row = row0 + ai * 128 + m * 16;
#define RSRDEF float rsr; if (rs_lds) rsr = rs_lds[u.ix * 256 + (row & 255)]; else { const f32x4* pp = (const f32x4*)(PS + (size_t)row * 16); const f32x4 p0 = pp[0], p1 = pp[1], p2 = pp[2], p3 = pp[3]; \
    const float ssum = ((p0[0] + p0[1]) + (p0[2] + p0[3])) + ((p1[0] + p1[1]) + (p1[2] + p1[3])) + ((p2[0] + p2[1]) + (p2[2] + p2[3])) + ((p3[0] + p3[1]) + (p3[2] + p3[3])); \
    rsr = 1.0f / sqrtf(ssum * (1.f / DM) + 1e-6f); }

struct Epi1 {
    static constexpr bool PERM = true, AFTER_DRAIN = false;
    bf16_t *U, *ZS, *XQ, *XZ; float* out;
    DI void operator()(const f32x4 (&acc)[2][2][4][2], const pg8::Unit& u, int wr, int wc, int fr, int fq) const {
        const int row0 = u.pm * 256 + wr * 64 + fr; const int pn = u.pn; const int cw = wc * 32 + 8 * fq;
        if (pn < 8) {
            const int ch0 = pn * 128 + cw;
            ROWLOOP { ROWDEF
                f32x4 u0, u1;
#pragma unroll
                for (int j = 0; j < 4; ++j) { u0[j] = acc[ai][0][m][0][j] * sigmoidf_(acc[ai][1][m][0][j]); u1[j] = acc[ai][0][m][1][j] * sigmoidf_(acc[ai][1][m][1][j]); }
                *(u32x4*)(U + (size_t)row * DM + ch0) = pack8(u0, u1);
                float* cp = nullptr;
                if (row < TP) { const int t = row & 16383; if (t >= 16354) cp = out + O_CONVP + ((size_t)((row >> 14) * 30 + (t - 16354))) * DM + ch0; }
                else { const int r2 = row - TP, t = r2 & 63; if (t >= 34) cp = out + O_CONVS + ((size_t)((r2 >> 6) * 30 + (t - 34))) * DM + ch0; }
                if (cp) { *(f32x4*)cp = u0; *(f32x4*)(cp + 4) = u1; }
             }
        } else if (pn < 12) {
#pragma unroll
            for (int bj = 0; bj < 2; ++bj) { const int col = (pn - 8) * 256 + bj * 128 + cw;
                ROWLOOP { ROWDEF  f32x4 a = acc[ai][bj][m][0], b = acc[ai][bj][m][1];
#pragma unroll
                    for (int j = 0; j < 4; ++j) { a[j] = siluf_(a[j]); b[j] = siluf_(b[j]); }
                    *(u32x4*)(ZS + (size_t)row * DM + col) = pack8(a, b);  } }
        } else if (pn < 14) {
#pragma unroll
            for (int bj = 0; bj < 2; ++bj) { const int col = (pn - 12) * 256 + bj * 128 + cw;
                ROWLOOP { ROWDEF  *(u32x4*)(XQ + (size_t)row * 512 + col) = pack8(acc[ai][bj][m][0] * XSCALE, acc[ai][bj][m][1] * XSCALE);  } }
        } else {
#pragma unroll
            for (int bj = 0; bj < 2; ++bj) { const int col = (pn - 14) * 256 + bj * 128 + cw;
                ROWLOOP { ROWDEF  f32x4 a = acc[ai][bj][m][0], b = acc[ai][bj][m][1];
#pragma unroll
                    for (int j = 0; j < 4; ++j) { a[j] = siluf_(a[j]); b[j] = siluf_(b[j]); }
                    *(u32x4*)(XZ + (size_t)row * 512 + col) = pack8(a, b);  } }
        }
    }
};

struct Epi3 {
    static constexpr bool PERM = true, AFTER_DRAIN = false;
    bf16_t *Q, *KB, *VB, *ZS, *XQ, *XZ; float* out; const float* PS; const LAS float* rs_lds;
    DI void operator()(const f32x4 (&acc)[2][2][4][2], const pg8::Unit& u, int wr, int wc, int fr, int fq) const {
        const int row0 = u.pm * 256 + wr * 64 + fr; const int pn = u.pn; const int cw = wc * 32 + 8 * fq;
        if (pn < 5) {
            const int d1 = 16 * (wc & 1) + 4 * fq;
            float invrev[4];
#pragma unroll
            for (int j = 0; j < 4; ++j) invrev[j] = __builtin_amdgcn_exp2f(-(float)(d1 + j) * 0.41524101186092033f) * 0.15915494309189535f;
            ROWLOOP { ROWDEF RSRDEF
                const int pos = row < TP ? (row & 16383) : 2048 + ((row - TP) & 63);
                float cs[4], sn[4];
#pragma unroll
                for (int j = 0; j < 4; ++j) { const float rr = __builtin_amdgcn_fractf((float)pos * invrev[j]); cs[j] = __builtin_amdgcn_cosf(rr); sn[j] = __builtin_amdgcn_sinf(rr); }
                if (pn < 4) {
#pragma unroll
                    for (int bj = 0; bj < 2; ++bj) { const int head = pn * 4 + bj * 2 + (wc >> 1);
                        f32x4 x1 = (acc[ai][bj][m][0] * rsr), x2 = (acc[ai][bj][m][1] * rsr), o1, o2;
#pragma unroll
                        for (int j = 0; j < 4; ++j) { o1[j] = (x1[j] * cs[j] - x2[j] * sn[j]) * QSCALE; o2[j] = (x2[j] * cs[j] + x1[j] * sn[j]) * QSCALE; }
                        bf16_t* qp = Q + (size_t)row * DM + head * 64 + d1;
                        u32x2 w1, w2; w1.x = pk2(o1[0], o1[1]); w1.y = pk2(o1[2], o1[3]); w2.x = pk2(o2[0], o2[1]); w2.y = pk2(o2[2], o2[3]);
                        *(u32x2*)qp = w1; *(u32x2*)(qp + 32) = w2; }
                } else {
                    float* kc = nullptr; float* vc = nullptr;
                    if (row < TP) { const int t = row & 16383; if (t >= 16256) { const size_t o = ((size_t)((row >> 14) * 128 + (t - 16256))) * 128; kc = out + O_KP + o; vc = out + O_VP + o; } }
                    else { const int r2 = row - TP; const size_t o = ((size_t)((r2 >> 6) * 128 + 64 + (r2 & 63))) * 128; kc = out + O_KS + o; vc = out + O_VS + o; }
                    { const int kvh = wc >> 1;
                        f32x4 x1 = (acc[ai][0][m][0] * rsr), x2 = (acc[ai][0][m][1] * rsr), o1, o2;
#pragma unroll
                        for (int j = 0; j < 4; ++j) { o1[j] = x1[j] * cs[j] - x2[j] * sn[j]; o2[j] = x2[j] * cs[j] + x1[j] * sn[j]; }
                        bf16_t* kp = KB + (size_t)row * 128 + kvh * 64 + d1;
                        u32x2 w1, w2; w1.x = pk2(o1[0], o1[1]); w1.y = pk2(o1[2], o1[3]); w2.x = pk2(o2[0], o2[1]); w2.y = pk2(o2[2], o2[3]);
                        *(u32x2*)kp = w1; *(u32x2*)(kp + 32) = w2;
                        if (kc) { *(f32x4*)(kc + kvh * 64 + d1) = o1; *(f32x4*)(kc + kvh * 64 + d1 + 32) = o2; } }
                    { f32x4 a = (acc[ai][1][m][0] * rsr), b = (acc[ai][1][m][1] * rsr);
                        *(u32x4*)(VB + (size_t)row * 128 + cw) = pack8(a, b);
                        if (vc) { *(f32x4*)(vc + cw) = a; *(f32x4*)(vc + cw + 4) = b; } }
                }
             }
        } else if (pn < 9) {
            ROWLOOP { ROWDEF RSRDEF
#pragma unroll
                for (int bj = 0; bj < 2; ++bj) { const int col = (pn - 5) * 256 + bj * 128 + cw;
                    f32x4 a = (acc[ai][bj][m][0] * rsr), b = (acc[ai][bj][m][1] * rsr);
#pragma unroll
                    for (int j = 0; j < 4; ++j) { a[j] = siluf_(a[j]); b[j] = siluf_(b[j]); }
                    *(u32x4*)(ZS + (size_t)row * DM + col) = pack8(a, b); } }
        } else if (pn < 11) {
            ROWLOOP { ROWDEF RSRDEF
#pragma unroll
                for (int bj = 0; bj < 2; ++bj) { const int col = (pn - 9) * 256 + bj * 128 + cw;
                    *(u32x4*)(XQ + (size_t)row * 512 + col) = pack8((acc[ai][bj][m][0] * rsr) * XSCALE, (acc[ai][bj][m][1] * rsr) * XSCALE); } }
        } else {
            ROWLOOP { ROWDEF RSRDEF
#pragma unroll
                for (int bj = 0; bj < 2; ++bj) { const int col = (pn - 11) * 256 + bj * 128 + cw;
                    f32x4 a = (acc[ai][bj][m][0] * rsr), b = (acc[ai][bj][m][1] * rsr);
#pragma unroll
                    for (int j = 0; j < 4; ++j) { a[j] = siluf_(a[j]); b[j] = siluf_(b[j]); }
                    *(u32x4*)(XZ + (size_t)row * 512 + col) = pack8(a, b); } }
        }
    }
};

struct Epi2 {
    static constexpr bool PERM = true, AFTER_DRAIN = false;
    const bf16_t* XB; bf16_t* X2;
    DI void operator()(const f32x4 (&acc)[2][2][4][2], const pg8::Unit& u, int wr, int wc, int fr, int fq) const {
        const int row0 = u.pm * 256 + wr * 64 + fr; const int cw = u.pn * 256 + wc * 32 + 8 * fq;
#pragma unroll
        for (int ai = 0; ai < 2; ++ai) {
            u32x4 res[4][2];
#pragma unroll
            for (int m = 0; m < 4; ++m)
#pragma unroll
                for (int bj = 0; bj < 2; ++bj) res[m][bj] = *(const u32x4*)(XB + (size_t)(row0 + ai * 128 + m * 16) * DM + cw + bj * 128);
            asm volatile("" ::: "memory");
#pragma unroll
            for (int m = 0; m < 4; ++m)
#pragma unroll
                for (int bj = 0; bj < 2; ++bj) { const u32x4 r = res[m][bj];
                    const f32x4 v0 = (f32x4){bflo(r.x), bfhi(r.x), bflo(r.y), bfhi(r.y)} + acc[ai][bj][m][0], v1 = (f32x4){bflo(r.z), bfhi(r.z), bflo(r.w), bfhi(r.w)} + acc[ai][bj][m][1];
                    *(u32x4*)(X2 + (size_t)(row0 + ai * 128 + m * 16) * DM + cw + bj * 128) = pack8(v0, v1); }
            asm volatile("" ::: "memory");
        }
    }
};

struct SplitOrder {
    int c;
    __device__ bool next(int i, pg8::Unit& u) const { if (i > 0 || c >= 64) return false; u.pm = 128 + (c >> 4); u.pn = (c >> 2) & 3; u.ko = (c & 3) * 384; u.ix = 0; return true; }
    DI void a_ready(const pg8::Unit&) const {}
    DI void done(const pg8::Unit&) const {}
};
struct OneTile {
    int pm, pn;
    __device__ bool next(int i, pg8::Unit& u) const { if (i > 0) return false; u.pm = pm; u.pn = pn; u.ko = 0; u.ix = 0; return true; }
    DI void a_ready(const pg8::Unit&) const {}
    DI void done(const pg8::Unit&) const {}
};
struct Order3 {
    int G, c;
    __device__ bool next(int i, pg8::Unit& u) const {
        const int L = i * G + c; if (L >= 1536) return false;
        const int wgid = (L & 7) * 192 + (L >> 3);
        if (wgid < 1248) { const int gid = wgid / 104, w = wgid % 104; u.pm = gid * 8 + (w & 7); u.pn = w >> 3; }
        else { const int w2 = wgid - 1248, gid = w2 / 72, w = w2 % 72; u.pm = 96 + gid * 8 + (w & 7); u.pn = w >> 3; }
        u.ko = 0; u.ix = i; return true;
    }
    DI void a_ready(const pg8::Unit&) const {}
    DI void done(const pg8::Unit&) const {}
};
struct EpiPart {
    static constexpr bool PERM = true, AFTER_DRAIN = false;
    float* part;
    DI void operator()(const f32x4 (&acc)[2][2][4][2], const pg8::Unit& u, int wr, int wc, int fr, int fq) const {
        const int row0 = (u.pm - 128) * 256 + wr * 64 + fr; const int cw = u.pn * 256 + wc * 32 + 8 * fq;
        float* base = part + (size_t)(u.ko / 384) * (TSMP * DM);
        ROWLOOP { ROWDEF
            float* dst = base + (size_t)row * DM;
#pragma unroll
            for (int bj = 0; bj < 2; ++bj) { *(f32x4*)(dst + cw + bj * 128) = acc[ai][bj][m][0]; *(f32x4*)(dst + cw + bj * 128 + 4) = acc[ai][bj][m][1]; }
        }
    }
};
struct Epi2a {
    static constexpr bool PERM = true, AFTER_DRAIN = false;
    const float* xp; bf16_t* XB; float* PS;
    DI void operator()(const f32x4 (&acc)[2][2][4][2], const pg8::Unit& u, int wr, int wc, int fr, int fq) const {
        const int row0 = u.pm * 256 + wr * 64 + fr; const int cw = u.pn * 256 + wc * 32 + 8 * fq;
#pragma unroll
        for (int ai = 0; ai < 2; ++ai) {
            f32x4 res[4][2][2];
#pragma unroll
            for (int m = 0; m < 4; ++m) { const float* src = xp + (size_t)(row0 + ai * 128 + m * 16) * DM + cw;
#pragma unroll
                for (int bj = 0; bj < 2; ++bj) { res[m][bj][0] = *(const f32x4*)(src + bj * 128); res[m][bj][1] = *(const f32x4*)(src + bj * 128 + 4); } }
            asm volatile("" ::: "memory");
#pragma unroll
            for (int m = 0; m < 4; ++m) { const int row = row0 + ai * 128 + m * 16;
                bf16_t* xb = XB + (size_t)row * DM;
                float ss = 0.f;
#pragma unroll
                for (int bj = 0; bj < 2; ++bj) { const int col = cw + bj * 128;
                    const f32x4 v0 = res[m][bj][0] + acc[ai][bj][m][0], v1 = res[m][bj][1] + acc[ai][bj][m][1];
                    *(u32x4*)(xb + col) = pack8(v0, v1);
                    ss += (v0[0] * v0[0] + v0[1] * v0[1]) + (v0[2] * v0[2] + v0[3] * v0[3]) + (v1[0] * v1[0] + v1[1] * v1[1]) + (v1[2] * v1[2] + v1[3] * v1[3]); }
                ss += __shfl_xor(ss, 16); ss += __shfl_xor(ss, 32);
                if (fq == 0) PS[(size_t)row * 16 + u.pn * 4 + wc] = ss;
            }
            asm volatile("" ::: "memory");
        }
    }
};
struct EpiM {
    static constexpr bool PERM = true, AFTER_DRAIN = false;
    bf16_t *MK, *MV; float* out;
    DI void operator()(const f32x4 (&acc)[2][2][4][2], const pg8::Unit& u, int wr, int wc, int fr, int fq) const {
        const int row0 = u.pm * 256 + wr * 64 + fr;
#pragma unroll
        for (int bj = 0; bj < 2; ++bj) { const int c = u.pn * 256 + bj * 128 + wc * 32 + 8 * fq; const int layer = c >> 10, e = c & 1023, isv = e >> 9, e2 = e & 511;
            ROWLOOP { ROWDEF  const size_t o = ((size_t)((layer * 2 + (row >> 8)) * 256 + (row & 255))) * 512 + e2;
                float* fo = out + (isv ? O_MVP : O_MKP) + o; bf16_t* bo = (isv ? MV : MK) + o;
                *(f32x4*)fo = acc[ai][bj][m][0]; *(f32x4*)(fo + 4) = acc[ai][bj][m][1];
                *(u32x4*)bo = pack8(acc[ai][bj][m][0], acc[ai][bj][m][1]);  } }
    }
};

DI int map_conv(int n) { if (n < 2048) { const int ch = n & 1023; return ((ch >> 7) << 8) + ((n >> 10) << 7) + (ch & 127); } return n; }
DI int ropepos(int d) { return 32 * ((d & 31) >> 4) + 8 * ((d >> 2) & 3) + 4 * (d >> 5) + (d & 3); }
DI int map_attn(int n) { if (n < 1152) return (n & ~63) + ropepos(n & 63); return n; }
template <int MAP> DI void transpose_item(const float* W, int K, int N, bf16_t* WT, LAS float* scr, int item, int lane, const float* gain = nullptr) {
    const int nblk = N / 32, kb = item / nblk, nb = item % nblk, k0 = 64 * kb, n0 = 32 * nb;
    float tv[32];
#pragma unroll
    for (int i = 0; i < 32; ++i) tv[i] = W[(size_t)(k0 + 2 * i + (lane >> 5)) * N + n0 + (lane & 31)];
#pragma unroll
    for (int i = 0; i < 32; ++i) scr[(2 * i + (lane >> 5)) * 33 + (lane & 31)] = tv[i];
    asm volatile("s_waitcnt lgkmcnt(0)" ::: "memory");
    const int c = lane & 7;
#pragma unroll
    for (int j = 0; j < 4; ++j) { const int n = (lane >> 3) + 8 * j; const LAS float* s = scr + (8 * c) * 33 + n;
        f32x4 g0 = {1.f, 1.f, 1.f, 1.f}, g1 = g0; if (gain) { g0 = *(const f32x4*)(gain + k0 + 8 * c); g1 = *(const f32x4*)(gain + k0 + 8 * c + 4); }
        u32x4 o; o.x = pk2(s[0 * 33] * g0[0], s[1 * 33] * g0[1]); o.y = pk2(s[2 * 33] * g0[2], s[3 * 33] * g0[3]); o.z = pk2(s[4 * 33] * g1[0], s[5 * 33] * g1[1]); o.w = pk2(s[6 * 33] * g1[2], s[7 * 33] * g1[3]);
        const int nn = n0 + n; const int dr = MAP == 1 ? map_conv(nn) : (MAP == 2 ? map_attn(nn) : nn);
        *(u32x4*)(WT + (size_t)dr * K + k0 + 8 * c) = o; }
    asm volatile("s_waitcnt lgkmcnt(0)" ::: "memory");
}
DI void rms_row_bf16(const float* xrow, const float* g, bf16_t* orow, int lane) {
    const f32x4* xr = (const f32x4*)xrow + lane; const f32x4* gr = (const f32x4*)g + lane;
    f32x4 v[4]; float s = 0.f;
#pragma unroll
    for (int j = 0; j < 4; ++j) { v[j] = xr[64 * j]; s += (v[j].x * v[j].x + v[j].y * v[j].y) + (v[j].z * v[j].z + v[j].w * v[j].w); }
    const float rstd = 1.0f / sqrtf(wave_sum(s) * (1.f / DM) + 1e-6f);
    u32x2* o8 = (u32x2*)orow + lane;
#pragma unroll
    for (int j = 0; j < 4; ++j) { const f32x4 gg = gr[64 * j]; u32x2 w; w.x = pk2(v[j].x * rstd * gg.x, v[j].y * rstd * gg.y); w.y = pk2(v[j].z * rstd * gg.z, v[j].w * rstd * gg.w); o8[64 * j] = w; }
}
DI void rms_row_final(const bf16_t* xrow, float* orow, const float* g, int lane, const float* part) {
    const u32x2* xr = (const u32x2*)xrow + lane; const f32x4* gr = (const f32x4*)g + lane; f32x4* o4 = (f32x4*)orow + lane;
    f32x4 v[4]; float s = 0.f;
#pragma unroll
    for (int j = 0; j < 4; ++j) { const u32x2 r = xr[64 * j]; v[j] = (f32x4){bflo(r.x), bfhi(r.x), bflo(r.y), bfhi(r.y)};
        if (part) {
#pragma unroll
            for (int ks = 0; ks < 4; ++ks) v[j] += ((const f32x4*)(part + (size_t)ks * TSMP * DM) + lane)[64 * j]; }
        s += (v[j].x * v[j].x + v[j].y * v[j].y) + (v[j].z * v[j].z + v[j].w * v[j].w); }
    const float rstd = 1.0f / sqrtf(wave_sum(s) * (1.f / DM) + 1e-6f);
#pragma unroll
    for (int j = 0; j < 4; ++j) { const f32x4 gg = gr[64 * j]; o4[64 * j] = v[j] * rstd * gg; }
}

template <int R> DI void rms_rows_bf16(const float* xp, const float* xs, int m0, int stride, const float* g, bf16_t* H, int lane) {
    f32x4 v[R][4];
#pragma unroll
    for (int k = 0; k < R; ++k) { const int mm = m0 + k * stride; const f32x4* xr = (const f32x4*)(mm < TP ? xp + (size_t)mm * DM : xs + (size_t)(mm - TP) * DM) + lane;
#pragma unroll
        for (int j = 0; j < 4; ++j) v[k][j] = xr[64 * j]; }
    f32x4 gg[4];
#pragma unroll
    for (int j = 0; j < 4; ++j) gg[j] = ((const f32x4*)g + lane)[64 * j];
#pragma unroll
    for (int k = 0; k < R; ++k) { float s = 0.f;
#pragma unroll
        for (int j = 0; j < 4; ++j) s += (v[k][j].x * v[k][j].x + v[k][j].y * v[k][j].y) + (v[k][j].z * v[k][j].z + v[k][j].w * v[k][j].w);
        const float rstd = 1.0f / sqrtf(wave_sum(s) * (1.f / DM) + 1e-6f);
        u32x2* o8 = (u32x2*)(H + (size_t)(m0 + k * stride) * DM) + lane;
#pragma unroll
        for (int j = 0; j < 4; ++j) { u32x2 w; w.x = pk2(v[k][j].x * rstd * gg[j].x, v[k][j].y * rstd * gg[j].y); w.y = pk2(v[k][j].z * rstd * gg[j].z, v[k][j].w * rstd * gg[j].w); o8[64 * j] = w; } }
}
template <int R> DI void rms_rows_final(const bf16_t* X2, float* out, int m0, int stride, const float* g, int lane) {
    u32x2 rr[R][4];
#pragma unroll
    for (int k = 0; k < R; ++k) { const u32x2* xr = (const u32x2*)(X2 + (size_t)(m0 + k * stride) * DM) + lane;
#pragma unroll
        for (int j = 0; j < 4; ++j) rr[k][j] = xr[64 * j]; }
    f32x4 gg[4];
#pragma unroll
    for (int j = 0; j < 4; ++j) gg[j] = ((const f32x4*)g + lane)[64 * j];
#pragma unroll
    for (int k = 0; k < R; ++k) { f32x4 v[4]; float s = 0.f;
#pragma unroll
        for (int j = 0; j < 4; ++j) { v[j] = (f32x4){bflo(rr[k][j].x), bfhi(rr[k][j].x), bflo(rr[k][j].y), bfhi(rr[k][j].y)}; s += (v[j].x * v[j].x + v[j].y * v[j].y) + (v[j].z * v[j].z + v[j].w * v[j].w); }
        const float rstd = 1.0f / sqrtf(wave_sum(s) * (1.f / DM) + 1e-6f);
        f32x4* o4 = (f32x4*)(out + (size_t)(m0 + k * stride) * DM) + lane;
#pragma unroll
        for (int j = 0; j < 4; ++j) o4[64 * j] = v[j] * rstd * gg[j]; }
}

DI void prologue(const Args& a, LAS unsigned char* lds, int G) {
    const int tid = threadIdx.x, lane = tid & 63, wave = __builtin_amdgcn_readfirstlane(tid >> 6);
    LAS float* scr = (LAS float*)(lds + wave * 16384);
    const int gw = blockIdx.x * 8 + wave, NGW = G * 8;
    unsigned char* ws = a.ws;
    constexpr int I_C = 16 * 128, I_A = 16 * 104, I_O = 24 * 32, I_M = 16 * 32;
    constexpr int NITEMS = I_C + I_A + 2 * I_O + 2 * I_M;
    for (int it = gw; it < NITEMS; it += NGW) {
        int r = it;
        if (r < I_C) { transpose_item<1>(a.in[9], 1024, 4096, (bf16_t*)(ws + WS_WC), scr, r, lane); continue; } r -= I_C;
        if (r < I_A) { transpose_item<2>(a.in[14], 1024, 3328, (bf16_t*)(ws + WS_WA), scr, r, lane, a.in[8] + DM); continue; } r -= I_A;
        if (r < 2 * I_O) { const int l = r / I_O; transpose_item<0>(a.in[17] + (size_t)l * 1536 * 1024, 1536, 1024, (bf16_t*)(ws + WS_WO) + (size_t)l * 1024 * 1536, scr, r % I_O, lane); continue; } r -= 2 * I_O;
        { const int l = r / I_M; transpose_item<0>(a.in[16] + (size_t)l * 1024 * 1024, 1024, 1024, (bf16_t*)(ws + WS_WM) + (size_t)l * 1024 * 1024, scr, r % I_M, lane); }
    }
    bf16_t* H = (bf16_t*)(ws + WS_H);
    { int m = gw;
      for (; m + 3 * NGW < TT; m += 4 * NGW) rms_rows_bf16<4>(a.in[0], a.in[1], m, NGW, a.in[8], H, lane);
      for (; m < TT; m += NGW) rms_rows_bf16<1>(a.in[0], a.in[1], m, NGW, a.in[8], H, lane); }
    const int gt = blockIdx.x * NTHR + tid, NGT = G * NTHR;
    { bf16_t* MP = (bf16_t*)(ws + WS_MP); for (int i = gt; i < 512 * 1024 / 8; i += NGT) *(u32x4*)(MP + (size_t)i * 8) = pack8f(a.in[7] + (size_t)i * 8); }
    for (int i = gt; i < 2 * 16 * 2048; i += NGT) { const int which = i >> 15, r = i & 32767, b = r >> 11, o = r & 2047;
        const f32x4 v = *(const f32x4*)(a.in[3 + which] + (size_t)(b * 128 + 64) * 128 + o * 4);
        *(f32x4*)(a.out + (which ? O_VS : O_KS) + (size_t)(b * 128) * 128 + o * 4) = v; }
}

#define MFMA32(a, b, c) __builtin_amdgcn_mfma_f32_32x32x16_bf16((a), (b), (c), 0, 0, 0)
typedef short v4i16_t __attribute__((ext_vector_type(4)));
DI s16x4 v_tr(const LAS unsigned char* p) { return __builtin_bit_cast(s16x4, __builtin_amdgcn_ds_read_tr16_b64_v4i16((LAS v4i16_t*)p)); }
DI int v_lane_off(int r, int h) { const int lane = r + 32 * h; return ((lane >> 4) & 1) * 32 + (lane & 3) * 8 + (4 * h + ((lane & 15) >> 2)) * 64; }
template <int NKT, int NDS, int NDT, int KSTR, int VSTR, bool SINK>
DI void attn_core(const LAS unsigned char* Kl, const LAS unsigned char* Vl, const bf16x8 (&qf)[NDS], int kt0, float sink, f32x16 (&o)[NDT], float& rl, int r, int h) {
    f32x16 s[NKT];
#pragma unroll
    for (int kt = 0; kt < NKT; ++kt) {
        if (kt >= kt0) {
#pragma unroll
            for (int i = 0; i < 16; ++i) s[kt][i] = 0.f;
#pragma unroll
            for (int ds = 0; ds < NDS; ++ds) { const bf16x8 ka = *(const LAS bf16x8*)(Kl + (kt * 32 + r) * KSTR + ds * 32 + h * 16); s[kt] = MFMA32(ka, qf[ds], s[kt]); }
        } else {
#pragma unroll
            for (int i = 0; i < 16; ++i) s[kt][i] = -INFINITY;
        }
    }
    float m = -INFINITY;
#pragma unroll
    for (int kt = 0; kt < NKT; ++kt)
#pragma unroll
        for (int i = 0; i < 16; ++i) m = fmaxf(m, s[kt][i]);
    m = fmaxf(m, __shfl_xor(m, 32));
    if (SINK) m = fmaxf(m, sink);
    float l = 0.f;
#pragma unroll
    for (int kt = 0; kt < NKT; ++kt)
#pragma unroll
        for (int i = 0; i < 16; ++i) { s[kt][i] = __builtin_amdgcn_exp2f(s[kt][i] - m); l += s[kt][i]; }
    l += __shfl_xor(l, 32);
    if (SINK) l += __builtin_amdgcn_exp2f(sink - m);
    rl = 1.0f / l;
#pragma unroll
    for (int dt = 0; dt < NDT; ++dt)
#pragma unroll
        for (int i = 0; i < 16; ++i) o[dt][i] = 0.f;
#pragma unroll
    for (int kt = 0; kt < NKT; ++kt) {
        if (kt >= kt0) {
#pragma unroll
            for (int st = 0; st < 2; ++st) {
                u32x4 pw; pw.x = pk2(s[kt][8 * st + 0], s[kt][8 * st + 1]); pw.y = pk2(s[kt][8 * st + 2], s[kt][8 * st + 3]); pw.z = pk2(s[kt][8 * st + 4], s[kt][8 * st + 5]); pw.w = pk2(s[kt][8 * st + 6], s[kt][8 * st + 7]);
                const bf16x8 pb = __builtin_bit_cast(bf16x8, pw);
#pragma unroll
                for (int dt = 0; dt < NDT; ++dt) {
                    const LAS unsigned char* vp = Vl + dt * VSTR + (kt * 32 + 16 * st) * 64 + v_lane_off(r, h);
                    const s16x4 lo = v_tr(vp), hi = v_tr(vp + 512);
                    const bf16x8 va = __builtin_shufflevector(lo, hi, 0, 1, 2, 3, 4, 5, 6, 7);
                    o[dt] = MFMA32(va, pb, o[dt]);
                }
            }
        }
    }
}
template <int NDS, int KSTR> DI void ld_kfrag(bf16x8 (&ka)[NDS], const LAS unsigned char* Kl, int kt, int r, int h) {
#pragma unroll
    for (int ds = 0; ds < NDS; ++ds) ka[ds] = *(const LAS bf16x8*)(Kl + (kt * 32 + r) * KSTR + ds * 32 + h * 16);
}
template <int NKT, int NDS, int NDT, int KSTR, int VSTR, bool SINK>
DI void attn_core3(const LAS unsigned char* Kl, const LAS unsigned char* Vl, const bf16x8 (&qf)[NDS], int kt0, float sink, f32x16 (&o)[NDT], float& rl, int r, int h) {
    float m = -INFINITY;
    const int ktb = SINK ? kt0 : 0;
    bf16x8 ka[NDS];
    ld_kfrag<NDS, KSTR>(ka, Kl, ktb, r, h);
#pragma unroll
    for (int kt = 0; kt < NKT; ++kt) {
        if (!SINK || kt >= kt0) {
            f32x16 s;
#pragma unroll
            for (int i = 0; i < 16; ++i) s[i] = 0.f;
#pragma unroll
            for (int ds = 0; ds < NDS; ++ds) s = MFMA32(ka[ds], qf[ds], s);
            asm volatile("" ::: "memory");
            if (kt + 1 < NKT) ld_kfrag<NDS, KSTR>(ka, Kl, kt + 1, r, h);
#pragma unroll
            for (int i = 0; i < 16; ++i) m = fmaxf(m, s[i]);
            asm volatile("" ::: "memory");
        }
    }
    m = fmaxf(m, __shfl_xor(m, 32));
    if (SINK) m = fmaxf(m, sink);
    asm volatile("" : "+v"(m) :: "memory");
    float l = 0.f;
#pragma unroll
    for (int dt = 0; dt < NDT; ++dt)
#pragma unroll
        for (int i = 0; i < 16; ++i) o[dt][i] = 0.f;
    ld_kfrag<NDS, KSTR>(ka, Kl, ktb, r, h);
#pragma unroll
    for (int kt = 0; kt < NKT; ++kt) {
        if (!SINK || kt >= kt0) {
            bf16x8 va[2][NDT];
#pragma unroll
            for (int st = 0; st < 2; ++st)
#pragma unroll
                for (int dt = 0; dt < NDT; ++dt) {
                    const LAS unsigned char* vp = Vl + dt * VSTR + (kt * 32 + 16 * st) * 64 + v_lane_off(r, h);
                    const s16x4 lo = v_tr(vp), hi = v_tr(vp + 512);
                    va[st][dt] = __builtin_shufflevector(lo, hi, 0, 1, 2, 3, 4, 5, 6, 7); }
            f32x16 s;
#pragma unroll
            for (int i = 0; i < 16; ++i) s[i] = -m;
#pragma unroll
            for (int ds = 0; ds < NDS; ++ds) s = MFMA32(ka[ds], qf[ds], s);
            asm volatile("" ::: "memory");
            if (kt + 1 < NKT) ld_kfrag<NDS, KSTR>(ka, Kl, kt + 1, r, h);
#pragma unroll
            for (int i = 0; i < 16; ++i) { s[i] = __builtin_amdgcn_exp2f(s[i]); l += s[i]; }
#pragma unroll
            for (int st = 0; st < 2; ++st) {
                u32x4 pw; pw.x = pk2(s[8 * st + 0], s[8 * st + 1]); pw.y = pk2(s[8 * st + 2], s[8 * st + 3]); pw.z = pk2(s[8 * st + 4], s[8 * st + 5]); pw.w = pk2(s[8 * st + 6], s[8 * st + 7]);
                const bf16x8 pb = __builtin_bit_cast(bf16x8, pw);
#pragma unroll
                for (int dt = 0; dt < NDT; ++dt) o[dt] = MFMA32(va[st][dt], pb, o[dt]);
            }
            asm volatile("" ::: "memory");
        }
    }
    l += __shfl_xor(l, 32);
    if (SINK) l += __builtin_amdgcn_exp2f(sink - m);
    rl = 1.0f / l;
}
template <int NKT, int NDS, int NDT, int KSTR, int VSTR, bool SINK>
DI void attn_core2(const LAS unsigned char* Kl, const LAS unsigned char* Vl, const bf16x8 (&qf)[NDS], int kt0, float sink, f32x16 (&o)[NDT], float& rl, int r, int h) {
    float m = -INFINITY;
#pragma unroll
    for (int kt = 0; kt < NKT; ++kt) {
        if (SINK && kt < kt0) continue;
        f32x16 s;
#pragma unroll
        for (int i = 0; i < 16; ++i) s[i] = 0.f;
#pragma unroll
        for (int ds = 0; ds < NDS; ++ds) { const bf16x8 ka = *(const LAS bf16x8*)(Kl + (kt * 32 + r) * KSTR + ds * 32 + h * 16); s = MFMA32(ka, qf[ds], s); }
#pragma unroll
        for (int i = 0; i < 16; ++i) m = fmaxf(m, s[i]);
    }
    m = fmaxf(m, __shfl_xor(m, 32));
    if (SINK) m = fmaxf(m, sink);
    asm volatile("" : "+v"(m) :: "memory");
    float l = 0.f;
#pragma unroll
    for (int dt = 0; dt < NDT; ++dt)
#pragma unroll
        for (int i = 0; i < 16; ++i) o[dt][i] = 0.f;
#pragma unroll
    for (int kt = 0; kt < NKT; ++kt) {
        if (SINK && kt < kt0) continue;
        f32x16 s;
#pragma unroll
        for (int i = 0; i < 16; ++i) s[i] = -m;
#pragma unroll
        for (int ds = 0; ds < NDS; ++ds) { const bf16x8 ka = *(const LAS bf16x8*)(Kl + (kt * 32 + r) * KSTR + ds * 32 + h * 16); s = MFMA32(ka, qf[ds], s); }
#pragma unroll
        for (int i = 0; i < 16; ++i) { s[i] = __builtin_amdgcn_exp2f(s[i]); l += s[i]; }
#pragma unroll
        for (int st = 0; st < 2; ++st) {
            u32x4 pw; pw.x = pk2(s[8 * st + 0], s[8 * st + 1]); pw.y = pk2(s[8 * st + 2], s[8 * st + 3]); pw.z = pk2(s[8 * st + 4], s[8 * st + 5]); pw.w = pk2(s[8 * st + 6], s[8 * st + 7]);
            const bf16x8 pb = __builtin_bit_cast(bf16x8, pw);
#pragma unroll
            for (int dt = 0; dt < NDT; ++dt) {
                const LAS unsigned char* vp = Vl + dt * VSTR + (kt * 32 + 16 * st) * 64 + v_lane_off(r, h);
                const s16x4 lo = v_tr(vp), hi = v_tr(vp + 512);
                const bf16x8 va = __builtin_shufflevector(lo, hi, 0, 1, 2, 3, 4, 5, 6, 7);
                o[dt] = MFMA32(va, pb, o[dt]);
            }
        }
        asm volatile("" ::: "memory");
    }
    l += __shfl_xor(l, 32);
    if (SINK) l += __builtin_amdgcn_exp2f(sink - m);
    rl = 1.0f / l;
}
DI void vt_write8(LAS unsigned char* Vl, int vstr, int d0, int key, u32x4 v) {
    LAS unsigned short* p = (LAS unsigned short*)(Vl + d0 * vstr + key * 2); const int st = vstr / 2;
    p[0 * st] = (unsigned short)(v.x & 0xffff); p[1 * st] = (unsigned short)(v.x >> 16); p[2 * st] = (unsigned short)(v.y & 0xffff); p[3 * st] = (unsigned short)(v.y >> 16);
    p[4 * st] = (unsigned short)(v.z & 0xffff); p[5 * st] = (unsigned short)(v.z >> 16); p[6 * st] = (unsigned short)(v.w & 0xffff); p[7 * st] = (unsigned short)(v.w >> 16);
}

constexpr int MEM_KSTR = 272, MEM_VSTR = 256 * 64, MEM_VOFF = 256 * MEM_KSTR;
DI void memattn_unit(const Args& a, LAS unsigned char* lds, int layer, int unit) {
    const int tid = threadIdx.x, lane = tid & 63, w = __builtin_amdgcn_readfirstlane(tid >> 6), r = lane & 31, h = lane >> 5;
    unsigned char* ws = a.ws;
    int b, hd, tok0, ntok; bool sample;
    if (unit < 512) { b = unit >> 8; hd = (unit >> 6) & 3; tok0 = b * 16384 + (unit & 63) * 256; ntok = 256; sample = false; }
    else { const int s = unit - 512; b = s >> 2; hd = s & 3; tok0 = TP + b * 64; ntok = 64; sample = true; }
    LAS unsigned char* Kl = lds; LAS unsigned char* Vl = lds + MEM_VOFF;
    const bool act = w * 32 < ntok;
    const bf16_t* XZ = (const bf16_t*)(ws + WS_XZ); bf16_t* A2 = (bf16_t*)(ws + WS_A2);
    bf16x8 qf[8]; u32x4 zv[8];
    if (!sample) {
        const bf16_t* Kg = (const bf16_t*)(ws + WS_MK) + ((size_t)(layer * 2 + b) * 256) * 512 + hd * 128;
        const bf16_t* Vg = (const bf16_t*)(ws + WS_MV) + ((size_t)(layer * 2 + b) * 256) * 512 + hd * 128;
        u32x4 kk[8], vv[8];
#pragma unroll
        for (int it = 0; it < 8; ++it) { const int ci = tid + NTHR * it;
            kk[it] = *(const u32x4*)(Kg + (size_t)(ci >> 4) * 512 + (ci & 15) * 8);
            vv[it] = *(const u32x4*)(Vg + (size_t)(ci >> 4) * 512 + (ci & 15) * 8); }
        { const bf16_t* qp = (const bf16_t*)(ws + WS_XQ) + ((size_t)tok0 + w * 32 + r) * 512 + hd * 128 + h * 8;
#pragma unroll
            for (int ds = 0; ds < 8; ++ds) qf[ds] = *(const bf16x8*)(qp + ds * 16); }
#pragma unroll
        for (int it = 0; it < 8; ++it) { const int ci = tid + NTHR * it;
            *(LAS u32x4*)(Kl + (ci >> 4) * MEM_KSTR + (ci & 15) * 16) = kk[it];
            *(LAS u32x4*)(Vl + ((ci & 15) >> 2) * MEM_VSTR + (ci >> 4) * 64 + (ci & 3) * 16) = vv[it]; }
    } else {
        const float* Kg = a.in[5] + ((size_t)(layer * 16 + b) * 256) * 512 + hd * 128;
        const float* Vg = a.in[6] + ((size_t)(layer * 16 + b) * 256) * 512 + hd * 128;
        if (act) { const bf16_t* qp = (const bf16_t*)(ws + WS_XQ) + ((size_t)tok0 + w * 32 + r) * 512 + hd * 128 + h * 8;
#pragma unroll
            for (int ds = 0; ds < 8; ++ds) qf[ds] = *(const bf16x8*)(qp + ds * 16); }
#pragma unroll 4
        for (int it = 0; it < 8; ++it) { const int ci = tid + NTHR * it;
            { const int key = ci >> 4, c8 = ci & 15; *(LAS u32x4*)(Kl + key * MEM_KSTR + c8 * 16) = pack8f(Kg + (size_t)key * 512 + c8 * 8); }
            { const int key = ci >> 4, c8 = ci & 15; *(LAS u32x4*)(Vl + (c8 >> 2) * MEM_VSTR + key * 64 + (c8 & 3) * 16) = pack8f(Vg + (size_t)key * 512 + c8 * 8); } }
    }
    __syncthreads();
    u32x2 ost[16];
    if (act) {
        f32x16 o[4]; float rl;
        attn_core2<8, 8, 4, MEM_KSTR, MEM_VSTR, false>(Kl, Vl, qf, 0, 0.f, o, rl, r, h);
#pragma unroll
        for (int i = 0; i < 8; ++i) zv[i] = *(const u32x4*)(XZ + ((size_t)tok0 + w * 32 + i * 4 + (lane >> 4)) * 512 + hd * 128 + (lane & 15) * 8);
#pragma unroll
        for (int dt = 0; dt < 4; ++dt)
#pragma unroll
            for (int g = 0; g < 4; ++g) { ost[dt * 4 + g].x = pk2(o[dt][4 * g + 0] * rl, o[dt][4 * g + 1] * rl); ost[dt * 4 + g].y = pk2(o[dt][4 * g + 2] * rl, o[dt][4 * g + 3] * rl); }
    }
    __syncthreads();
    if (act) {
        LAS unsigned char* stg = lds + w * (32 * MEM_KSTR);
#pragma unroll
        for (int dt = 0; dt < 4; ++dt)
#pragma unroll
            for (int g = 0; g < 4; ++g) *(LAS u32x2*)(stg + r * MEM_KSTR + (dt * 32 + 8 * g + 4 * h) * 2) = ost[dt * 4 + g];
#pragma unroll
        for (int i = 0; i < 8; ++i) { const int row = i * 4 + (lane >> 4), ch = lane & 15; const size_t tk = (size_t)tok0 + w * 32 + row;
            const u32x4 ov = *(const LAS u32x4*)(stg + row * MEM_KSTR + ch * 16); const u32x4 z4 = zv[i];
            u32x4 rv; rv.x = pk2(bflo(ov.x) * bflo(z4.x), bfhi(ov.x) * bfhi(z4.x)); rv.y = pk2(bflo(ov.y) * bflo(z4.y), bfhi(ov.y) * bfhi(z4.y));
            rv.z = pk2(bflo(ov.z) * bflo(z4.z), bfhi(ov.z) * bfhi(z4.z)); rv.w = pk2(bflo(ov.w) * bflo(z4.w), bfhi(ov.w) * bfhi(z4.w));
            *(u32x4*)(A2 + tk * 1536 + 1024 + hd * 128 + ch * 8) = rv; }
    }
    __syncthreads();
}

constexpr int SWA_KSTR = 144, SWA_VSTR = 192 * 64, SWA_VOFF = 192 * SWA_KSTR, SWA_STG_OFF = 53248;
struct SwaPre { u32x4 kv[3], vv[3]; bf16x8 qf[4]; };
DI void swa_decode(int unit, int& b, int& kvh, int& tok0, int& kt0, bool& sample) {
    if (unit < 1024) { const int k = unit >> 8, cb = unit & 255; b = k >> 1; kvh = k & 1; const int c = (cb & 7) * 32 + (cb >> 3);
        tok0 = b * 16384 + c * 64; kt0 = c >= 2 ? 0 : (2 - c) * 2; sample = false; }
    else { const int s = unit - 1024; b = s >> 1; kvh = s & 1; tok0 = TP + b * 64; kt0 = 0; sample = true; }
}
DI void swa_issue(const Args& a, int unit, SwaPre& P) {
    const int tid = threadIdx.x, lane = tid & 63, w = __builtin_amdgcn_readfirstlane(tid >> 6), r = lane & 31, h = lane >> 5;
    unsigned char* ws = a.ws;
    int b, kvh, tok0, kt0; bool sample; swa_decode(unit, b, kvh, tok0, kt0, sample);
    const bf16_t* KB = (const bf16_t*)(ws + WS_K); const bf16_t* VB = (const bf16_t*)(ws + WS_V);
    if (!sample) {
        const int tmin = b * 16384;
#pragma unroll
        for (int it = 0; it < 3; ++it) { const int ci = tid + NTHR * it;
            { const int key = ci >> 3, c8 = ci & 7; int tk = tok0 - 128 + key; tk = tk < tmin ? tmin : tk; P.kv[it] = *(const u32x4*)(KB + (size_t)tk * 128 + kvh * 64 + c8 * 8); }
            { const int key = ci >> 3, c8 = ci & 7; int tk = tok0 - 128 + key; tk = tk < tmin ? tmin : tk; P.vv[it] = *(const u32x4*)(VB + (size_t)tk * 128 + kvh * 64 + c8 * 8); } }
    } else {
#pragma unroll
        for (int it = 0; it < 3; ++it) { const int ci = tid + NTHR * it;
            { const int key = ci >> 3, c8 = ci & 7;
                if (key < 128) P.kv[it] = pack8f(a.in[3] + ((size_t)(b * 128 + key) * 2 + kvh) * 64 + c8 * 8);
                else P.kv[it] = *(const u32x4*)(KB + (size_t)(tok0 - 128 + key) * 128 + kvh * 64 + c8 * 8); }
            { const int key = ci >> 3, c8 = ci & 7;
                if (key < 128) P.vv[it] = pack8f(a.in[4] + ((size_t)(b * 128 + key) * 2 + kvh) * 64 + c8 * 8);
                else P.vv[it] = *(const u32x4*)(VB + (size_t)(tok0 - 128 + key) * 128 + kvh * 64 + c8 * 8); } }
    }
    const int head = kvh * 8 + w;
    { const bf16_t* qp = (const bf16_t*)(ws + WS_U) + ((size_t)tok0 + r) * DM + head * 64 + h * 8;
#pragma unroll
        for (int ds = 0; ds < 4; ++ds) P.qf[ds] = *(const bf16x8*)(qp + ds * 16); }
}
DI void swa_phase(const Args& a, LAS unsigned char* lds, int first, int stride, int nunits) {
    const int tid = threadIdx.x, lane = tid & 63, w = __builtin_amdgcn_readfirstlane(tid >> 6), r = lane & 31, h = lane >> 5;
    unsigned char* ws = a.ws;
    LAS unsigned char* Kl = lds; LAS unsigned char* Vl = lds + SWA_VOFF;
    const bf16_t* ZS = (const bf16_t*)(ws + WS_Z); bf16_t* A2 = (bf16_t*)(ws + WS_A2);
    if (first >= nunits) return;
    SwaPre P; swa_issue(a, first, P);
#pragma unroll 1
    for (int unit = first; unit < nunits; unit += stride) {
        int b, kvh, tok0, kt0; bool sample; swa_decode(unit, b, kvh, tok0, kt0, sample);
        const int head = kvh * 8 + w;
#pragma unroll
        for (int it = 0; it < 3; ++it) { const int ci = tid + NTHR * it;
            { const int key = ci >> 3, c8 = ci & 7; *(LAS u32x4*)(Kl + key * SWA_KSTR + c8 * 16) = P.kv[it]; }
            { const int key = ci >> 3, c8 = ci & 7; *(LAS u32x4*)(Vl + (c8 >> 2) * SWA_VSTR + key * 64 + (c8 & 3) * 16) = P.vv[it]; } }
        bf16x8 qf[2][4];
#pragma unroll
        for (int ds = 0; ds < 4; ++ds) qf[0][ds] = P.qf[ds];
        __syncthreads();
        if (unit + stride < nunits) swa_issue(a, unit + stride, P);
        { const bf16_t* qp = (const bf16_t*)(ws + WS_U) + ((size_t)tok0 + 32 + r) * DM + head * 64 + h * 8;
#pragma unroll
            for (int ds = 0; ds < 4; ++ds) qf[1][ds] = *(const bf16x8*)(qp + ds * 16); }
        u32x4 zv[2][4];
        const float sink = a.in[15][head] * LOG2E;
#pragma unroll
        for (int qb = 0; qb < 2; ++qb) {
            f32x16 o[2]; float rl;
            attn_core3<6, 4, 2, SWA_KSTR, SWA_VSTR, true>(Kl, Vl, qf[qb], kt0, sink, o, rl, r, h);
#pragma unroll
            for (int i = 0; i < 4; ++i) zv[qb][i] = *(const u32x4*)(ZS + ((size_t)tok0 + qb * 32 + i * 8 + (lane >> 3)) * DM + head * 64 + (lane & 7) * 8);
            LAS unsigned char* stg = lds + SWA_STG_OFF + w * (32 * 144);
#pragma unroll
            for (int dt = 0; dt < 2; ++dt)
#pragma unroll
                for (int g = 0; g < 4; ++g) { u32x2 ov; ov.x = pk2(o[dt][4 * g + 0] * rl, o[dt][4 * g + 1] * rl); ov.y = pk2(o[dt][4 * g + 2] * rl, o[dt][4 * g + 3] * rl);
                    *(LAS u32x2*)(stg + r * 144 + (dt * 32 + 8 * g + 4 * h) * 2) = ov; }
#pragma unroll
            for (int i = 0; i < 4; ++i) { const int row = i * 8 + (lane >> 3), ch = lane & 7; const size_t tk = (size_t)tok0 + qb * 32 + row;
                const u32x4 ov = *(const LAS u32x4*)(stg + row * 144 + ch * 16); const u32x4 z4 = zv[qb][i];
                u32x4 rv; rv.x = pk2(bflo(ov.x) * bflo(z4.x), bfhi(ov.x) * bfhi(z4.x)); rv.y = pk2(bflo(ov.y) * bflo(z4.y), bfhi(ov.y) * bfhi(z4.y));
                rv.z = pk2(bflo(ov.z) * bflo(z4.z), bfhi(ov.z) * bfhi(z4.z)); rv.w = pk2(bflo(ov.w) * bflo(z4.w), bfhi(ov.w) * bfhi(z4.w));
                *(u32x4*)(A2 + tk * 1536 + head * 64 + ch * 8) = rv; }
            asm volatile("" ::: "memory");
        }
        __syncthreads();
    }
}

template <int I> DI void conv_row(f32x2 (&acc)[32], const f32x2 (&wk)[31], const LAS unsigned char* lds, int rb, int tid) {
    const unsigned uv = *(const LAS unsigned*)(lds + ((rb + I) & 63) * 2048 + tid * 4); const f32x2 uf = {bflo(uv), bfhi(uv)};
    constexpr int T0 = I > 30 ? I - 30 : 0, T1 = I < 31 ? I : 31;
#pragma unroll
    for (int t = T0; t <= T1; ++t) acc[t] += wk[I - t] * uf;
    if constexpr ((I & 3) == 3) asm volatile("" ::: "memory");
    if constexpr (I + 1 < 62) conv_row<I + 1>(acc, wk, lds, rb, tid);
}
constexpr int CONV_RED_OFF = 131072, CONV_STAT_OFF = 131072 + 2048;
DI void conv_run(const Args& a, LAS unsigned char* lds, bool sample, int b, int tile0, int ntiles, const f32x2 (&wk)[31], const f32x2 cb, const f32x2 lg, const f32x2 lb) {
    const int tid = threadIdx.x, lane = tid & 63, w = __builtin_amdgcn_readfirstlane(tid >> 6);
    unsigned char* ws = a.ws;
    const int tfirst0 = tile0 * 32; const int tokbase0 = (sample ? TP + b * 64 : b * 16384) + tfirst0;
    const bf16_t* U = (const bf16_t*)(ws + WS_U); const bf16_t* ZS = (const bf16_t*)(ws + WS_Z); bf16_t* A2 = (bf16_t*)(ws + WS_A2);
    const int prow = tid >> 7, pc = tid & 127;
    u32x4 nw[8];
    {
        const bf16_t* np = U + (size_t)(tokbase0 + prow) * DM + pc * 8;
#pragma unroll
        for (int it = 0; it < 8; ++it) nw[it] = *(const u32x4*)(np + (size_t)it * 4 * DM);
        if (tfirst0 >= 32) {
            const bf16_t* hp = U + (size_t)(tokbase0 - 30 + prow) * DM + pc * 8; u32x4 hv[8];
#pragma unroll
            for (int it = 0; it < 7; ++it) hv[it] = *(const u32x4*)(hp + (size_t)it * 4 * DM);
            if (prow < 2) hv[7] = *(const u32x4*)(hp + (size_t)7 * 4 * DM);
#pragma unroll
            for (int it = 0; it < 7; ++it) *(LAS u32x4*)(lds + (it * 4 + prow) * 2048 + pc * 16) = hv[it];
            if (prow < 2) *(LAS u32x4*)(lds + (28 + prow) * 2048 + pc * 16) = hv[7];
        } else {
            for (int idx = tid; idx < 30 * 128; idx += NTHR) { const int i = idx >> 7, c = idx & 127; u32x4 v;
                if (sample) v = pack8f(a.in[2] + ((size_t)(b * 30 + i)) * DM + c * 8); else v = (u32x4){0u, 0u, 0u, 0u};
                *(LAS u32x4*)(lds + i * 2048 + c * 16) = v; }
        }
#pragma unroll
        for (int it = 0; it < 8; ++it) *(LAS u32x4*)(lds + (30 + it * 4 + prow) * 2048 + pc * 16) = nw[it];
    }
    __syncthreads();
#pragma unroll 1
    for (int j = 0; j < ntiles; ++j) {
        const int rb = (32 * j) & 63; const int tokbase = tokbase0 + 32 * j; const bool more = j + 1 < ntiles;
        if (more) { const bf16_t* np = U + (size_t)(tokbase + 32 + prow) * DM + pc * 8;
#pragma unroll
            for (int it = 0; it < 8; ++it) nw[it] = *(const u32x4*)(np + (size_t)it * 4 * DM); }
        f32x2 acc[32];
#pragma unroll
        for (int t = 0; t < 32; ++t) acc[t] = cb;
        conv_row<0>(acc, wk, lds, rb, tid);
        __syncthreads();
        if (more) {
#pragma unroll
            for (int it = 0; it < 8; ++it) *(LAS u32x4*)(lds + ((rb + 62 + it * 4 + prow) & 63) * 2048 + pc * 16) = nw[it]; }
        float vals[64];
#pragma unroll
        for (int t = 0; t < 32; ++t) { vals[t] = acc[t].x + acc[t].y; vals[32 + t] = acc[t].x * acc[t].x + acc[t].y * acc[t].y; }
#define BFLY(off) { const bool up = (lane & (off)) != 0; _Pragma("unroll") for (int jj = 0; jj < (off); ++jj) { const float send = up ? vals[jj] : vals[jj + (off)]; const float keep = up ? vals[jj + (off)] : vals[jj]; vals[jj] = keep + __shfl_xor(send, (off)); } }
        BFLY(32) BFLY(16) BFLY(8) BFLY(4) BFLY(2) BFLY(1)
#undef BFLY
        LAS float* red = (LAS float*)(lds + CONV_RED_OFF); LAS f32x2* stat = (LAS f32x2*)(lds + CONV_STAT_OFF);
        red[w * 64 + lane] = vals[0];
        asm volatile("" ::: "memory");
        unsigned zq[32];
#pragma unroll
        for (int t = 0; t < 32; ++t) zq[t] = *(const unsigned*)(ZS + (size_t)(tokbase + t) * DM + 2 * tid);
        __syncthreads();
        if (tid < 32) { float s1 = 0.f, s2 = 0.f;
#pragma unroll
            for (int ww = 0; ww < 8; ++ww) { s1 += red[ww * 64 + tid]; s2 += red[ww * 64 + 32 + tid]; }
            const float mean = s1 * (1.f / DM); const float var = fmaxf(s2 * (1.f / DM) - mean * mean, 0.f);
            stat[tid] = (f32x2){mean, 1.0f / sqrtf(var + 1e-5f)}; }
        __syncthreads();
#pragma unroll
        for (int t = 0; t < 32; ++t) { const f32x2 st = stat[t]; const unsigned zv = zq[t];
            const float y0 = (acc[t].x - st.x) * st.y * lg.x + lb.x, y1 = (acc[t].y - st.x) * st.y * lg.y + lb.y;
            *(unsigned*)(A2 + (size_t)(tokbase + t) * 1536 + 2 * tid) = pk2(siluf_(y0) * bflo(zv), siluf_(y1) * bfhi(zv)); }
    }
    __syncthreads();
}

#define XB_TMO      128
#define XB_XCNT(j)  (256  + 64 * (j))
#define XB_XSUB(j)  (1280 + 64 * (j))
#define XB_XGEN(j)  (2304 + 64 * (j))
#define XB_TOP      3328
#define XB_TOPGEN   3392
#define XCD_BAR_WORDS 3456
#define XB_SPIN_CAP (1u << 18)

__device__ __forceinline__ unsigned xb_ld(unsigned* p)              { return __hip_atomic_load(p, __ATOMIC_RELAXED, __HIP_MEMORY_SCOPE_AGENT); }
__device__ __forceinline__ unsigned xb_add(unsigned* p, unsigned v) { return __hip_atomic_fetch_add(p, v, __ATOMIC_RELAXED, __HIP_MEMORY_SCOPE_AGENT); }
__device__ __forceinline__ unsigned xb_xcc_id() { return (unsigned)__builtin_amdgcn_s_getreg((3 << 11) | 20) & 0xFu; }
#define XB_SPIN(cond, bar) do { unsigned _sp = 0; while (cond) { __builtin_amdgcn_s_sleep(1); \
    if ((++_sp & 255u) == 0u) { if (xb_ld(&(bar)[XB_TMO])) break; if (_sp > XB_SPIN_CAP) { atomicAdd(&(bar)[XB_TMO], 1u); break; } } } } while (0)

struct XcdBarrier {
    unsigned* bar; unsigned x;
    volatile LAS unsigned* st;
};

__device__ __forceinline__ XcdBarrier xcd_barrier_post(unsigned* bar, volatile LAS unsigned* st) {
    XcdBarrier b; b.bar = bar; b.x = xb_xcc_id(); b.st = st;
    if (threadIdx.x == 0) (void)xb_add(&bar[XB_XCNT(b.x)], 1u);
    return b;
}
__device__ __forceinline__ void xcd_barrier_complete(unsigned* bar, unsigned x, unsigned& nloc, unsigned& nx) {
    const unsigned G = gridDim.x * gridDim.y * gridDim.z;
    unsigned sum, cnt, mine, sp = 0u;
    for (;;) {
        sum = 0u; cnt = 0u; mine = 0u;
#pragma unroll
        for (unsigned j = 0; j < 16; ++j) { const unsigned c = xb_ld(&bar[XB_XCNT(j)]); sum += c; cnt += (c > 0u) ? 1u : 0u; mine = (j == x) ? c : mine; }
        if (sum == G) break;
        __builtin_amdgcn_s_sleep(1);
        if ((++sp & 255u) == 0u) { if (xb_ld(&bar[XB_TMO])) break; if (sp > XB_SPIN_CAP) { atomicAdd(&bar[XB_TMO], 1u); break; } }
    }
    nloc = mine > 0u ? mine : 1u; nx = cnt > 0u ? cnt : 1u;
}

__device__ __forceinline__ void xcd_barrier(const XcdBarrier& b) {
    asm volatile("s_waitcnt vmcnt(0)" ::: "memory");
    __syncthreads();
    if (threadIdx.x == 0) {
        unsigned* bar = b.bar;
        __builtin_amdgcn_s_waitcnt(0);
        unsigned nloc = b.st[0], nx = b.st[1];
        if (nloc == 0u) { xcd_barrier_complete(bar, b.x, nloc, nx); b.st[0] = nloc; b.st[1] = nx; }
        const unsigned old = xb_add(&bar[XB_XSUB(b.x)], 1u);
        const unsigned gen = old / nloc;
        if (old + 1u == (gen + 1u) * nloc) {
            __builtin_amdgcn_fence(__ATOMIC_RELEASE, "agent");
            asm volatile("s_waitcnt vmcnt(0)" ::: "memory");
            const unsigned og = xb_add(&bar[XB_TOP], 1u);
            const unsigned tg = og / nx;
            if (og + 1u == (tg + 1u) * nx) xb_add(&bar[XB_TOPGEN], 1u);
            else XB_SPIN(xb_ld(&bar[XB_TOPGEN]) == tg, bar);
            __builtin_amdgcn_fence(__ATOMIC_ACQUIRE, "agent");
            xb_add(&bar[XB_XGEN(b.x)], 1u);
            asm volatile("s_waitcnt vmcnt(0)" ::: "memory");
        } else {
            XB_SPIN(xb_ld(&bar[XB_XGEN(b.x)]) == gen, bar);
            __builtin_amdgcn_fence(__ATOMIC_ACQUIRE, "agent");
            asm volatile("s_waitcnt vmcnt(0)" ::: "memory");
        }
    }
    __syncthreads();
}

__global__ void __launch_bounds__(NTHR, 2) mega_fwd(Args a) {
    extern __shared__ __attribute__((aligned(16))) unsigned char lds_raw[];
    LAS unsigned char* lds = (LAS unsigned char*)lds_raw;
    cg::grid_group grid = cg::this_grid();
    const int G = gridDim.x, lo = a.ph_lo, hi = a.ph_hi;
    unsigned char* ws = a.ws;
#ifndef PH_DISABLE
#define PH_DISABLE 0
#endif
#define IN(k) (lo <= (k) && (k) < hi && !((PH_DISABLE >> (k)) & 1))
#define SEAM(k) do { if (IN(k) && IN((k) + 1)) xcd_barrier(bar); } while (0)
    { volatile LAS unsigned* st = (volatile LAS unsigned*)(lds + LDS_BYTES - 64);
      if (threadIdx.x < 2) st[threadIdx.x] = 0u;
      __syncthreads(); }
    XcdBarrier bar = xcd_barrier_post((unsigned*)(ws + WS_CTL) + (lo == 0 ? 0 : XCD_BAR_WORDS), (volatile LAS unsigned*)(lds + LDS_BYTES - 64));
    if (hi > 1000) grid.sync();
    if (IN(0)) { prologue(a, lds, G); }
    SEAM(0);
    if (IN(1)) {
        pg8::Gemm g{(const bf16_t*)(ws + WS_H), (const bf16_t*)(ws + WS_WC), TP, 4096, 1024, 1024}; pg8::StaticOrder S; S.init(TP, 4096, G, (int)blockIdx.x);
        Epi1 E{(bf16_t*)(ws + WS_U), (bf16_t*)(ws + WS_Z), (bf16_t*)(ws + WS_XQ), (bf16_t*)(ws + WS_XZ), a.out};
        pg8::gemm_phase<Epi1, pg8::StaticOrder, true, true>(lds, g, S, E);
    }
    SEAM(1);
    if (IN(2)) {
        unsigned* flag = (unsigned*)(ws + WS_CTL) + 7168;
        for (int e = blockIdx.x; e < 80; e += G) {
            if (e < 64) { pg8::Gemm g{(const bf16_t*)(ws + WS_H), (const bf16_t*)(ws + WS_WC), TT, 4096, 1024, 1024}; OneTile S{128 + (e >> 4), e & 15};
                Epi1 E{(bf16_t*)(ws + WS_U), (bf16_t*)(ws + WS_Z), (bf16_t*)(ws + WS_XQ), (bf16_t*)(ws + WS_XZ), a.out};
                pg8::gemm_phase<Epi1, OneTile, true, true>(lds, g, S, E); }
            else { pg8::Gemm g{(const bf16_t*)(ws + WS_MP), (const bf16_t*)(ws + WS_WM), 512, 2048, 1024, 1024}; OneTile S{(e - 64) >> 3, (e - 64) & 7};
                EpiM E{(bf16_t*)(ws + WS_MK), (bf16_t*)(ws + WS_MV), a.out};
                pg8::gemm_phase<EpiM, OneTile, true, true>(lds, g, S, E); }
            asm volatile("s_waitcnt vmcnt(0)" ::: "memory"); __syncthreads();
            if (threadIdx.x == 0) { __builtin_amdgcn_fence(__ATOMIC_RELEASE, "agent"); asm volatile("s_waitcnt vmcnt(0)" ::: "memory"); (void)xb_add(flag, 1u); }
        }
        { const int tid = threadIdx.x; f32x2 wk[31];
#pragma unroll
          for (int k = 0; k < 31; ++k) wk[k] = *(const f32x2*)(a.in[10] + k * DM + 2 * tid);
          const f32x2 cb = *(const f32x2*)(a.in[11] + 2 * tid), lg = *(const f32x2*)(a.in[12] + 2 * tid), lb = *(const f32x2*)(a.in[13] + 2 * tid);
          const int sfirst = G >= 96 ? G - 16 : 0;
#pragma unroll 1
          for (int pass = 0; pass < 2; ++pass) {
              if (pass == 1) {
                  if (threadIdx.x == 0) { unsigned sp = 0; while (xb_ld(flag) < 80u) { __builtin_amdgcn_s_sleep(2); if (++sp > (1u << 22)) break; }
                      __builtin_amdgcn_fence(__ATOMIC_ACQUIRE, "agent"); asm volatile("s_waitcnt vmcnt(0)" ::: "memory"); }
                  __syncthreads(); }
              const int lim = pass ? 16 : 256;
#pragma unroll 1
              for (int idx = (int)blockIdx.x - (pass ? sfirst : 0); idx >= 0 && idx < lim; idx += G)
                  conv_run(a, lds, pass != 0, pass ? idx : idx >> 7, pass ? 0 : (idx & 127) * 4, pass ? 2 : 4, wk, cb, lg, lb);
          }
        }
    }
    if (IN(3)) {
        if (G >= 96) { const int c = blockIdx.x;
            if (c < 80) memattn_unit(a, lds, 0, c);
            else for (int u = c; u < 576; u += G - 80) memattn_unit(a, lds, 0, u);
        } else for (int u = blockIdx.x; u < 576; u += G) memattn_unit(a, lds, 0, u);
    }
    SEAM(3);
    if (IN(4)) {
        { pg8::Gemm g{(const bf16_t*)(ws + WS_A2), (const bf16_t*)(ws + WS_WO), TP, 1024, 1536, 1536}; pg8::StaticOrder S; S.init(TP, 1024, G, (int)blockIdx.x);
          Epi2a E{a.in[0], (bf16_t*)(ws + WS_H), (float*)(ws + WS_PS)};
#ifndef NO_MAIN
          pg8::gemm_phase<Epi2a, pg8::StaticOrder, true, true>(lds, g, S, E);
#endif
        }
        { pg8::Gemm g{(const bf16_t*)(ws + WS_A2), (const bf16_t*)(ws + WS_WO), TT, 1024, 384, 1536}; SplitOrder S{(int)blockIdx.x};
          EpiPart E{(float*)(ws + WS_PART)};
#ifndef NO_TAIL
          pg8::gemm_phase<EpiPart, SplitOrder, true, true>(lds, g, S, E);
#endif
        }
    }
    do { if (IN(4) && IN(6)) xcd_barrier(bar); } while (0);
    if (IN(6)) {
        pg8::Gemm g{(const bf16_t*)(ws + WS_H), (const bf16_t*)(ws + WS_WA), TT, 3328, 1024, 1024}; Order3 S{G, (int)blockIdx.x};
        Epi3 E{(bf16_t*)(ws + WS_U), (bf16_t*)(ws + WS_K), (bf16_t*)(ws + WS_V), (bf16_t*)(ws + WS_Z), (bf16_t*)(ws + WS_XQ), (bf16_t*)(ws + WS_XZ), a.out, (const float*)(ws + WS_PS), G >= 192 ? (const LAS float*)(lds + 131072) : (const LAS float*)nullptr};
        {
            LAS float* rt = (LAS float*)(lds + 131072); const float* PSg = (const float*)(ws + WS_PS);
            for (int i = (int)(threadIdx.x >> 8); i < 8; i += 2) { pg8::Unit uu; if (!S.next(i, uu)) break;
                const f32x4* pp = (const f32x4*)(PSg + ((size_t)uu.pm * 256 + (threadIdx.x & 255)) * 16); const f32x4 p0 = pp[0], p1 = pp[1], p2 = pp[2], p3 = pp[3];
                const float ssum = ((p0[0] + p0[1]) + (p0[2] + p0[3])) + ((p1[0] + p1[1]) + (p1[2] + p1[3])) + ((p2[0] + p2[1]) + (p2[2] + p2[3])) + ((p3[0] + p3[1]) + (p3[2] + p3[3]));
                rt[i * 256 + (threadIdx.x & 255)] = 1.0f / sqrtf(ssum * (1.f / DM) + 1e-6f); }
            __syncthreads(); }
        pg8::gemm_phase<Epi3, Order3, true, true>(lds, g, S, E);
        {
        const int tid = threadIdx.x, lane = tid & 63, wave = __builtin_amdgcn_readfirstlane(tid >> 6);
        const int gw = blockIdx.x * 8 + wave, NGW = G * 8; bf16_t* XB = (bf16_t*)(ws + WS_H); float* PS = (float*)(ws + WS_PS);
        const float* PART = (const float*)(ws + WS_PART);
        for (int mm = TP + gw; mm < TT; mm += NGW) {
            const size_t ro = (size_t)(mm - TP) * DM;
            const f32x4* xr = (const f32x4*)(a.in[1] + ro) + lane; u32x2* o8 = (u32x2*)(XB + (size_t)mm * DM) + lane; float s = 0.f;
#pragma unroll
            for (int j = 0; j < 4; ++j) { f32x4 v = xr[64 * j];
#pragma unroll
                for (int ks = 0; ks < 4; ++ks) v += ((const f32x4*)(PART + (size_t)ks * TSMP * DM + ro) + lane)[64 * j];
                s += (v.x * v.x + v.y * v.y) + (v.z * v.z + v.w * v.w); u32x2 w; w.x = pk2(v.x, v.y); w.y = pk2(v.z, v.w); o8[64 * j] = w; }
            s = wave_sum(s);
            if (lane < 16) PS[(size_t)mm * 16 + lane] = lane == 0 ? s : 0.f;
        }
            }
    }
    SEAM(6);
    if (IN(7)) {
        unsigned* flag = (unsigned*)(ws + WS_CTL) + 7232;
        for (int e = blockIdx.x; e < 180; e += G) {
            pg8::Gemm g{(const bf16_t*)(ws + WS_H), (const bf16_t*)(ws + WS_WA), TT, 3328, 1024, 1024};
            OneTile S{e < 52 ? 128 + e / 13 : 96 + ((e - 52) >> 2), e < 52 ? e % 13 : 9 + ((e - 52) & 3)};
            Epi3 E{(bf16_t*)(ws + WS_U), (bf16_t*)(ws + WS_K), (bf16_t*)(ws + WS_V), (bf16_t*)(ws + WS_Z), (bf16_t*)(ws + WS_XQ), (bf16_t*)(ws + WS_XZ), a.out, (const float*)(ws + WS_PS), (const LAS float*)(lds + 131072)};
            { LAS float* rt = (LAS float*)(lds + 131072); const float* PSg = (const float*)(ws + WS_PS);
              if (threadIdx.x < 256) { const f32x4* pp = (const f32x4*)(PSg + ((size_t)S.pm * 256 + threadIdx.x) * 16); const f32x4 p0 = pp[0], p1 = pp[1], p2 = pp[2], p3 = pp[3];
                  const float ssum = ((p0[0] + p0[1]) + (p0[2] + p0[3])) + ((p1[0] + p1[1]) + (p1[2] + p1[3])) + ((p2[0] + p2[1]) + (p2[2] + p2[3])) + ((p3[0] + p3[1]) + (p3[2] + p3[3]));
                  rt[threadIdx.x] = 1.0f / sqrtf(ssum * (1.f / DM) + 1e-6f); }
              __syncthreads(); }
            pg8::gemm_phase<Epi3, OneTile, true, true>(lds, g, S, E);
            asm volatile("s_waitcnt vmcnt(0)" ::: "memory"); __syncthreads();
            if (threadIdx.x == 0) { __builtin_amdgcn_fence(__ATOMIC_RELEASE, "agent"); asm volatile("s_waitcnt vmcnt(0)" ::: "memory"); (void)xb_add(flag, 1u); }
        }
        const int sfirst = G >= 64 ? G - 32 : 0;
#pragma unroll 1
        for (int pass = 0; pass < 2; ++pass) {
            if (pass == 1) {
                if (threadIdx.x == 0) { unsigned sp = 0; while (xb_ld(flag) < 180u) { __builtin_amdgcn_s_sleep(2); if (++sp > (1u << 22)) break; }
                    __builtin_amdgcn_fence(__ATOMIC_ACQUIRE, "agent"); asm volatile("s_waitcnt vmcnt(0)" ::: "memory"); }
                __syncthreads(); }
            const int first = pass ? ((int)blockIdx.x >= sfirst ? 1024 + (int)blockIdx.x - sfirst : 1056) : (int)blockIdx.x;
            swa_phase(a, lds, first, G, pass ? 1056 : 1024);
        }
    }
    if (IN(8)) {
        const int c = blockIdx.x; const bool bal = G >= 224;
#pragma unroll 1
        for (int k = 0; ; ++k) { int u;
            if (!bal) u = c + k * G; else if (c < 180) u = k < 2 ? c + 180 * k : 576; else u = 360 + (c - 180) + k * (G - 180);
            if (u >= 576) break;
            memattn_unit(a, lds, 1, u); }
    }
    SEAM(8);
    if (IN(9)) {
        { pg8::Gemm g{(const bf16_t*)(ws + WS_A2), (const bf16_t*)(ws + WS_WO) + (size_t)1024 * 1536, TP, 1024, 1536, 1536}; pg8::StaticOrder S; S.init(TP, 1024, G, (int)blockIdx.x);
          Epi2 E{(const bf16_t*)(ws + WS_H), (bf16_t*)(ws + WS_U)};
          pg8::gemm_phase<Epi2, pg8::StaticOrder, true, true>(lds, g, S, E); }
        { pg8::Gemm g{(const bf16_t*)(ws + WS_A2), (const bf16_t*)(ws + WS_WO) + (size_t)1024 * 1536, TT, 1024, 384, 1536}; SplitOrder S{(int)blockIdx.x};
          EpiPart E{(float*)(ws + WS_PART)};
#ifndef NO_TAIL
          pg8::gemm_phase<EpiPart, SplitOrder, true, true>(lds, g, S, E);
#endif
        }
    }
    SEAM(9);
    if (IN(10)) {
        const int tid = threadIdx.x, lane = tid & 63, wave = __builtin_amdgcn_readfirstlane(tid >> 6);
        const int gw = blockIdx.x * 8 + wave, NGW = G * 8;
        { int m = gw;
          for (; m + 3 * NGW < TP; m += 4 * NGW) rms_rows_final<4>((const bf16_t*)(ws + WS_U), a.out, m, NGW, a.in[18], lane);
          for (; m < TP; m += NGW) rms_rows_final<1>((const bf16_t*)(ws + WS_U), a.out, m, NGW, a.in[18], lane);
          for (m = TP + gw; m < TT; m += NGW) rms_row_final((const bf16_t*)(ws + WS_H) + (size_t)m * DM, a.out + (size_t)m * DM, a.in[18], lane, (const float*)(ws + WS_PART) + (size_t)(m - TP) * DM); }
    }
#undef IN
#undef SEAM
}

#ifndef MK_ONE_LAUNCH
#define MK_ONE_LAUNCH 1
#endif
extern "C" void kernel_launch(void* const* d_in, const int* in_sizes, int n_in, void* d_out, int out_size, void* d_ws, size_t ws_size, hipStream_t stream) {
    static int grid = 0;
    if (grid == 0) {
        if (n_in != 19 || (size_t)out_size != O_TOTAL || ws_size < WS_END) { fprintf(stderr, "kernel_launch: unexpected shapes (n_in %d out %d ws %zu)\n", n_in, out_size, ws_size); grid = -1; return; }
        int dev = 0, cus = 0, per_cu = 0;
        (void)hipGetDevice(&dev); (void)hipDeviceGetAttribute(&cus, hipDeviceAttributeMultiprocessorCount, dev);
        if (hipFuncSetAttribute((const void*)mega_fwd, hipFuncAttributeMaxDynamicSharedMemorySize, LDS_BYTES) != hipSuccess) { fprintf(stderr, "kernel_launch: hipFuncSetAttribute failed\n"); grid = -1; return; }
        if (hipOccupancyMaxActiveBlocksPerMultiprocessor(&per_cu, (const void*)mega_fwd, NTHR, LDS_BYTES) != hipSuccess || per_cu < 1) { fprintf(stderr, "kernel_launch: occupancy query says %d\n", per_cu); per_cu = 1; }
        (void)hipGetLastError();
        grid = cus;
    }
    if (grid < 0) return;
    if (hipMemsetAsync((char*)d_ws + WS_CTL, 0, CTL_BYTES, stream) != hipSuccess) { fprintf(stderr, "kernel_launch: memset failed\n"); return; }
    Args a{};
    for (int i = 0; i < 19; ++i) a.in[i] = (const float*)d_in[i];
    a.out = (float*)d_out; a.ws = (unsigned char*)d_ws;
#if MK_ONE_LAUNCH
#ifdef PROBE_SPLIT
    { a.ph_lo = 0; a.ph_hi = PROBE_SPLIT + 1; void* args0[] = {&a};
      (void)hipLaunchCooperativeKernel((const void*)mega_fwd, dim3(grid), dim3(NTHR), args0, LDS_BYTES, stream);
      a.ph_lo = PROBE_SPLIT; }
#else
    a.ph_lo = 0;
#endif
    a.ph_hi = 11;
    void* args[] = {&a};
    hipError_t e = hipLaunchCooperativeKernel((const void*)mega_fwd, dim3(grid), dim3(NTHR), args, LDS_BYTES, stream);
    if (e != hipSuccess) fprintf(stderr, "kernel_launch: cooperative launch failed: %s (grid %d)\n", hipGetErrorString(e), grid);
#else
    for (int p = 0; p < 11; ++p) { a.ph_lo = p; a.ph_hi = p + 1; hipLaunchKernelGGL(mega_fwd, dim3(grid), dim3(NTHR), LDS_BYTES, stream, a); }
#endif
}
```

```cpp
#include <hip/hip_runtime.h>
#include <hip/hip_cooperative_groups.h>
#include <cstdio>
#include <cstdint>
namespace cg = cooperative_groups;
namespace pg8 {
#define PG8_LAS __attribute__((address_space(3)))
typedef unsigned short bf16_t;
typedef short bf16x8 __attribute__((ext_vector_type(8)));
typedef float f32x4 __attribute__((ext_vector_type(4)));
typedef unsigned u32x4 __attribute__((ext_vector_type(4)));
constexpr int BM = 256, BK = 64, HALF = 128, HTB = HALF * BK * 2  , STAGE_BYTES = 8 * HTB, NXCD = 8, WGM = 8;

__host__ __device__ __forceinline__ int lds_byte(int r, int c) { const int st = (r >> 4) * 2 + (c >> 5), rr = r & 15, cc = c & 31, ob = rr * 64 + cc * 2; return st * 1024 + (ob ^ (((ob >> 9) & 1) << 5)); }
__host__ __device__ __forceinline__ void stage_rc(int b, int& R, int& C) { const int st = b / 1024, sb = b % 1024, swz = sb ^ (((sb >> 9) & 1) << 5); R = (st >> 1) * 16 + swz / 64; C = (st & 1) * 32 + (swz % 64) / 2; }
__host__ __device__ __forceinline__ int perm32(int rho) { const int n = rho >> 4, i = rho & 15; return 8 * (i >> 2) + 4 * n + (i & 3); }

struct Unit { int pm, pn, ko, ix; };
struct Gemm { const bf16_t* A; const bf16_t* Bt; int M, N, K, ld; };

struct StaticOrder {
    int nM, nN, nwg, G, c;
    __host__ __device__ void init(int M, int N, int G_, int c_) { nM = M / BM; nN = N / BM; nwg = nM * nN; G = G_; c = c_; }
    __host__ __device__ bool next(int i, Unit& u) const {
        const long L = (long)i * G + c; if (L >= nwg) return false;
        int wgid = (int)L; { const int q = nwg / NXCD, r = nwg % NXCD, xcd = wgid % NXCD, off = wgid / NXCD; wgid = (xcd < r ? xcd * (q + 1) : r * (q + 1) + (xcd - r) * q) + off; }
        const int nig = WGM * nN, gid = wgid / nig, fm = gid * WGM, gsz = (nM - fm) < WGM ? (nM - fm) : WGM;
        u.pm = fm + ((wgid % nig) % gsz); u.pn = (wgid % nig) / gsz; u.ko = 0; u.ix = i; return true;
    }
    __device__ __forceinline__ void a_ready(const Unit&) const {}
    __device__ __forceinline__ void done(const Unit&) const {}
};

__device__ __forceinline__ unsigned cvt_pk_bf16(float lo, float hi) { unsigned r; asm volatile("v_cvt_pk_bf16_f32 %0, %1, %2" : "=v"(r) : "v"(lo), "v"(hi)); return r; }
typedef float f32x2 __attribute__((ext_vector_type(2)));
template <class Epi, class Sched, bool ALIGN_EPI = false, bool SP2 = false>
__device__ __forceinline__ void gemm_phase(PG8_LAS unsigned char* lds, const Gemm g, const Sched& S, const Epi& E) {
    const int tid = threadIdx.x, wid = __builtin_amdgcn_readfirstlane(tid >> 6), lane = tid & 63, wr = wid >> 2, wc = wid & 3, fr = lane & 15, fq = lane >> 4;
    const int K = g.ld, nt = g.K / BK;
    unsigned voffA[2], voffB[2];
#pragma unroll
    for (int i = 0; i < 2; ++i) { int R, C; stage_rc(tid * 16 + i * 8192, R, C); const int Rb = Epi::PERM ? ((R & ~31) + perm32(R & 31)) : R;
        voffA[i] = (unsigned)(R * K + C) * 2u; voffB[i] = (unsigned)(Rb * K + C) * 2u; }
    const size_t kstep = (size_t)(BK * 2);
    const size_t hstep = (size_t)HALF * K * 2;
    const size_t tstep = 2 * hstep;
    const unsigned ldsw = (unsigned)wid * 1024u;
    const int aoff = lds_byte(wr * 64 + fr, fq * 8), boff = lds_byte(wc * 32 + fr, fq * 8);
#define PG8_SA(b, h) (((b) * 2 + (h)) * HTB)
#define PG8_SB(b, h) ((4 + (b) * 2 + (h)) * HTB)
#define PG8_STAGE(bufoff, gbase, voff) do { _Pragma("unroll") for (int _i = 0; _i < 2; ++_i) \
        __builtin_amdgcn_global_load_lds((const unsigned*)((const char*)(gbase) + (voff)[_i]), (PG8_LAS unsigned*)(lds + (bufoff) + ldsw + _i * 8192), 16, 0, 0); } while (0)
#define PG8_LDA(dst, b, h) do { _Pragma("unroll") for (int m = 0; m < 4; ++m) _Pragma("unroll") for (int k = 0; k < 2; ++k) dst[m][k] = *(const PG8_LAS bf16x8*)(lds + PG8_SA(b, h) + aoff + m * 2048 + k * 1024); } while (0)
#define PG8_LDB(dst, b, h) do { _Pragma("unroll") for (int n = 0; n < 2; ++n) _Pragma("unroll") for (int k = 0; k < 2; ++k) dst[n][k] = *(const PG8_LAS bf16x8*)(lds + PG8_SB(b, h) + boff + n * 2048 + k * 1024); } while (0)
#define PG8_MMA(ai, bj, At, Bt) do { __builtin_amdgcn_s_setprio(1); _Pragma("unroll") for (int m = 0; m < 4; ++m) _Pragma("unroll") for (int n = 0; n < 2; ++n) _Pragma("unroll") for (int k = 0; k < 2; ++k) \
        acc[ai][bj][m][n] = __builtin_amdgcn_mfma_f32_16x16x32_bf16(Bt[n][k], At[m][k], acc[ai][bj][m][n], 0, 0, 0); __builtin_amdgcn_s_setprio(0); } while (0)
#define PG8_WAIT_V(n) asm volatile("s_waitcnt vmcnt(" #n ")" ::: "memory")
#define PG8_WAIT_L(n) asm volatile("s_waitcnt lgkmcnt(" #n ")" ::: "memory")
#define PG8_BAR __builtin_amdgcn_s_barrier()
#define PG8_SCHED __builtin_amdgcn_sched_barrier(0)
    Unit cur, nxt; int ui = 0;
    if (!S.next(0, cur)) return;
    f32x4 acc[2][2][4][2];
#pragma unroll
    for (int a = 0; a < 2; ++a)
#pragma unroll
        for (int b = 0; b < 2; ++b)
#pragma unroll
            for (int m = 0; m < 4; ++m)
#pragma unroll
                for (int n = 0; n < 2; ++n) acc[a][b][m][n] = (f32x4){0.f, 0.f, 0.f, 0.f};
    bf16x8 At[4][2], B0[2][2], B1[2][2];
    const char* cA = (const char*)g.A + (size_t)cur.pm * tstep + (size_t)cur.ko * 2; const char* cB = (const char*)g.Bt + (size_t)cur.pn * tstep + (size_t)cur.ko * 2;
    S.a_ready(cur);
    if constexpr (SP2) {
        PG8_STAGE(PG8_SB(0, 0), cB, voffB); PG8_STAGE(PG8_SB(0, 1), cB + hstep, voffB); PG8_STAGE(PG8_SA(0, 0), cA, voffA); PG8_STAGE(PG8_SA(0, 1), cA + hstep, voffA);
        if (wr == 1) PG8_BAR;
        PG8_WAIT_V(2); PG8_BAR;
        PG8_STAGE(PG8_SB(1, 0), cB + kstep, voffB); PG8_STAGE(PG8_SA(1, 0), cA + kstep, voffA); PG8_STAGE(PG8_SB(1, 1), cB + hstep + kstep, voffB);
        PG8_WAIT_V(6); PG8_BAR;
    } else {
        PG8_STAGE(PG8_SB(0, 0), cB, voffB); PG8_STAGE(PG8_SA(0, 0), cA, voffA); PG8_STAGE(PG8_SB(0, 1), cB + hstep, voffB); PG8_STAGE(PG8_SA(0, 1), cA + hstep, voffA);
        if (wr == 1) PG8_BAR;
        PG8_WAIT_V(4); PG8_BAR;
        PG8_STAGE(PG8_SB(1, 0), cB + kstep, voffB); PG8_STAGE(PG8_SA(1, 0), cA + kstep, voffA); PG8_STAGE(PG8_SB(1, 1), cB + hstep + kstep, voffB);
        PG8_WAIT_V(6); PG8_BAR;
    }
    for (;;) {
        const bool has_next = S.next(ui + 1, nxt);
        const char* nA = has_next ? (const char*)g.A + (size_t)nxt.pm * tstep + (size_t)nxt.ko * 2 : cA; const char* nB = has_next ? (const char*)g.Bt + (size_t)nxt.pn * tstep + (size_t)nxt.ko * 2 : cB;
#pragma unroll 1
        for (int t = 0; t < nt; t += 2) {
            const bool last = (t == nt - 2);
            const char* a1 = cA + (size_t)(t + 1) * kstep;
            const char* a2 = last ? nA : cA + (size_t)(t + 2) * kstep; const char* b2 = last ? nB : cB + (size_t)(t + 2) * kstep;
            const char* a3 = a2 + kstep; const char* b3 = b2 + kstep;
            if (last && has_next) S.a_ready(nxt);
            if constexpr (SP2) {
            PG8_LDB(B0, 0, 0); PG8_LDB(B1, 0, 1); PG8_SCHED; PG8_LDA(At, 0, 0); PG8_STAGE(PG8_SA(1, 1), a1 + hstep, voffA);
            PG8_WAIT_V(8); PG8_WAIT_L(0); PG8_BAR; PG8_MMA(0, 0, At, B0); PG8_MMA(0, 1, At, B1); PG8_BAR; PG8_SCHED;
            PG8_LDA(At, 0, 1); PG8_STAGE(PG8_SB(0, 0), b2, voffB); PG8_STAGE(PG8_SB(0, 1), b2 + hstep, voffB); PG8_STAGE(PG8_SA(0, 0), a2, voffA);
            PG8_WAIT_V(8); PG8_WAIT_L(0); PG8_BAR; PG8_MMA(1, 0, At, B0); PG8_MMA(1, 1, At, B1); PG8_BAR; PG8_SCHED;
            PG8_LDB(B0, 1, 0); PG8_LDB(B1, 1, 1); PG8_SCHED; PG8_LDA(At, 1, 0); PG8_STAGE(PG8_SA(0, 1), a2 + hstep, voffA);
            PG8_WAIT_V(8); PG8_WAIT_L(0); PG8_BAR; PG8_MMA(0, 0, At, B0); PG8_MMA(0, 1, At, B1); PG8_BAR; PG8_SCHED;
            PG8_LDA(At, 1, 1); PG8_STAGE(PG8_SB(1, 0), b3, voffB); PG8_STAGE(PG8_SB(1, 1), b3 + hstep, voffB); PG8_STAGE(PG8_SA(1, 0), a3, voffA);
            PG8_WAIT_V(8); PG8_WAIT_L(0); PG8_BAR; PG8_MMA(1, 0, At, B0); PG8_MMA(1, 1, At, B1); PG8_BAR; PG8_SCHED;
            } else {
            PG8_LDB(B0, 0, 0); PG8_SCHED; PG8_LDA(At, 0, 0); PG8_STAGE(PG8_SA(1, 1), a1 + hstep, voffA);
            PG8_WAIT_L(8); PG8_BAR; PG8_WAIT_L(0); PG8_MMA(0, 0, At, B0); PG8_BAR; PG8_SCHED;
            PG8_LDB(B1, 0, 1); PG8_STAGE(PG8_SB(0, 0), b2, voffB);
            PG8_BAR; PG8_WAIT_L(0); PG8_MMA(0, 1, At, B1); PG8_BAR;
            PG8_LDA(At, 0, 1); PG8_STAGE(PG8_SA(0, 0), a2, voffA);
            PG8_BAR; PG8_WAIT_L(0); PG8_MMA(1, 0, At, B0); PG8_BAR; PG8_SCHED;
            PG8_STAGE(PG8_SB(0, 1), b2 + hstep, voffB);
            PG8_WAIT_V(6); PG8_BAR; PG8_MMA(1, 1, At, B1); PG8_BAR;
            PG8_LDB(B0, 1, 0); PG8_SCHED; PG8_LDA(At, 1, 0); PG8_STAGE(PG8_SA(0, 1), a2 + hstep, voffA);
            PG8_WAIT_L(8); PG8_BAR; PG8_WAIT_L(0); PG8_MMA(0, 0, At, B0); PG8_BAR; PG8_SCHED;
            PG8_LDB(B1, 1, 1); PG8_STAGE(PG8_SB(1, 0), b3, voffB);
            PG8_BAR; PG8_WAIT_L(0); PG8_MMA(0, 1, At, B1); PG8_BAR;
            PG8_LDA(At, 1, 1); PG8_STAGE(PG8_SA(1, 0), a3, voffA);
            PG8_BAR; PG8_WAIT_L(0); PG8_MMA(1, 0, At, B0); PG8_BAR; PG8_SCHED;
            PG8_STAGE(PG8_SB(1, 1), b3 + hstep, voffB);
            PG8_WAIT_V(6); PG8_BAR; PG8_MMA(1, 1, At, B1); PG8_BAR;
            }
        }
        if constexpr (ALIGN_EPI) { if (wr == 0) PG8_BAR; }
        if constexpr (!Epi::AFTER_DRAIN) { E(acc, cur, wr, wc, fr, fq); S.done(cur); }
        if (!has_next) break;
#pragma unroll
        for (int a = 0; a < 2; ++a)
#pragma unroll
            for (int b = 0; b < 2; ++b)
#pragma unroll
                for (int m = 0; m < 4; ++m)
#pragma unroll
                    for (int n = 0; n < 2; ++n) acc[a][b][m][n] = (f32x4){0.f, 0.f, 0.f, 0.f};
        cur = nxt; cA = nA; cB = nB; ++ui;
        if constexpr (ALIGN_EPI) { if (wr == 1) PG8_BAR; }
    }
    PG8_WAIT_V(0);
    if constexpr (!ALIGN_EPI) { if (wr == 0) PG8_BAR; }
    PG8_BAR;
    if constexpr (Epi::AFTER_DRAIN) { E.fused(acc, cur, wr, wc, fr, fq, lds, wid, lane); S.done(cur); }
#undef PG8_SA
#undef PG8_SB
#undef PG8_STAGE
#undef PG8_LDA
#undef PG8_LDB
#undef PG8_MMA
#undef PG8_WAIT_V
#undef PG8_WAIT_L
#undef PG8_BAR
#undef PG8_SCHED
}
}


#define LAS __attribute__((address_space(3)))
#define DI __device__ __forceinline__
using pg8::bf16_t; using pg8::bf16x8; using pg8::f32x4; using pg8::u32x4;
typedef short s16x4 __attribute__((ext_vector_type(4)));
typedef float f32x16 __attribute__((ext_vector_type(16)));
typedef float f32x2 __attribute__((ext_vector_type(2)));
typedef unsigned u32x2 __attribute__((ext_vector_type(2)));
typedef __bf16 bf16x2_t __attribute__((ext_vector_type(2)));

constexpr int TP = 32768, TSMP = 1024, TT = TP + TSMP;
constexpr int DM = 1024;
constexpr int NTHR = 512;
constexpr float LOG2E = 1.4426950408889634f;
constexpr float QSCALE = 0.125f * LOG2E;
constexpr float XSCALE = 0.08838834764831845f * LOG2E;
constexpr size_t MiB = 1u << 20;
constexpr size_t WS_PART = 416 * MiB;
constexpr size_t WS_CTL = 31 * MiB, CTL_BYTES = 65536;
constexpr size_t WS_PS0 = 30 * MiB + 512 * 1024;
constexpr size_t WS_PS = 28 * MiB;
constexpr size_t WS_WC = 0, WS_WA = 8 * MiB, WS_WO = 15 * MiB, WS_WM = 21 * MiB, WS_MP = 25 * MiB, WS_MK = 26 * MiB, WS_MV = 27 * MiB;
constexpr size_t WS_H = 32 * MiB, WS_U = 98 * MiB, WS_Z = 164 * MiB, WS_XQ = 230 * MiB, WS_XZ = 263 * MiB, WS_A2 = 296 * MiB, WS_K = 395 * MiB, WS_V = 404 * MiB, WS_END = 432 * MiB;
constexpr size_t O_Y = 0, O_CONVP = 34603008, O_CONVS = 34664448, O_KP = 35155968, O_VP = 35188736, O_KS = 35221504, O_VS = 35483648, O_MKP = 35745792, O_MVP = 36270080, O_TOTAL = 36794368;
constexpr int LDS_BYTES = 147456;

struct Args {
    const float* in[19]; float* out; unsigned char* ws; int ph_lo, ph_hi;
};

DI unsigned pk2(float lo, float hi) { f32x2 v = {lo, hi}; bf16x2_t b = __builtin_convertvector(v, bf16x2_t); return __builtin_bit_cast(unsigned, b); }
DI float bflo(unsigned u) { return __uint_as_float(u << 16); }
DI float bfhi(unsigned u) { return __uint_as_float(u & 0xffff0000u); }
DI float sigmoidf_(float x) { return __builtin_amdgcn_rcpf(1.0f + __expf(-x)); }
DI float siluf_(float x) { return x * sigmoidf_(x); }
DI u32x4 pack8(f32x4 a, f32x4 b) { u32x4 w; w.x = pk2(a[0], a[1]); w.y = pk2(a[2], a[3]); w.z = pk2(b[0], b[1]); w.w = pk2(b[2], b[3]); return w; }
DI u32x4 pack8f(const float* s) { f32x4 a = *(const f32x4*)s, b = *(const f32x4*)(s + 4); return pack8(a, b); }
DI float wave_sum(float v) {
#pragma unroll
    for (int o = 1; o < 64; o <<= 1) v += __shfl_xor(v, o);
    return v;
}

#define ROWLOOP _Pragma("unroll") for (int ai = 0; ai < 2; ++ai) _Pragma("unroll") for (int m = 0; m < 4; ++m)
#define ROWDEF const int row = row0 + ai * 128 + m * 16;
#define RSRDEF float rsr; if (rs_lds) rsr = rs_lds[u.ix * 256 + (row & 255)]; else { const f32x4* pp = (const f32x4*)(PS + (size_t)row * 16); const f32x4 p0 = pp[0], p1 = pp[1], p2 = pp[2], p3 = pp[3]; \
    const float ssum = ((p0[0] + p0[1]) + (p0[2] + p0[3])) + ((p1[0] + p1[1]) + (p1[2] + p1[3])) + ((p2[0] + p2[1]) + (p2[2] + p2[3])) + ((p3[0] + p3[1]) + (p3[2] + p3[3])); \
    rsr = 1.0f / sqrtf(ssum * (1.f / DM) + 1e-6f); }

struct Epi1 {
    static constexpr bool PERM = true, AFTER_DRAIN = false;
    bf16_t *U, *ZS, *XQ, *XZ; float* out; const LAS float* rs0;
    DI void operator()(const f32x4 (&acc)[2][2][4][2], const pg8::Unit& u, int wr, int wc, int fr, int fq) const {
        const int row0 = u.pm * 256 + wr * 64 + fr; const int pn = u.pn; const int cw = wc * 32 + 8 * fq;
        if (pn < 8) {
            const int ch0 = pn * 128 + cw;
            ROWLOOP { ROWDEF const float rsr = rs0[u.ix * 256 + (row & 255)];
                f32x4 u0, u1;
#pragma unroll
                for (int j = 0; j < 4; ++j) { u0[j] = (acc[ai][0][m][0] * rsr)[j] * sigmoidf_((acc[ai][1][m][0] * rsr)[j]); u1[j] = (acc[ai][0][m][1] * rsr)[j] * sigmoidf_((acc[ai][1][m][1] * rsr)[j]); }
                *(u32x4*)(U + (size_t)row * DM + ch0) = pack8(u0, u1);
                float* cp = nullptr;
                if (row < TP) { const int t = row & 16383; if (t >= 16354) cp = out + O_CONVP + ((size_t)((row >> 14) * 30 + (t - 16354))) * DM + ch0; }
                else { const int r2 = row - TP, t = r2 & 63; if (t >= 34) cp = out + O_CONVS + ((size_t)((r2 >> 6) * 30 + (t - 34))) * DM + ch0; }
                if (cp) { *(f32x4*)cp = u0; *(f32x4*)(cp + 4) = u1; }
             }
        } else if (pn < 12) {
#pragma unroll
            for (int bj = 0; bj < 2; ++bj) { const int col = (pn - 8) * 256 + bj * 128 + cw;
                ROWLOOP { ROWDEF const float rsr = rs0[u.ix * 256 + (row & 255)];  f32x4 a = (acc[ai][bj][m][0] * rsr), b = (acc[ai][bj][m][1] * rsr);
#pragma unroll
                    for (int j = 0; j < 4; ++j) { a[j] = siluf_(a[j]); b[j] = siluf_(b[j]); }
                    *(u32x4*)(ZS + (size_t)row * DM + col) = pack8(a, b);  } }
        } else if (pn < 14) {
#pragma unroll
            for (int bj = 0; bj < 2; ++bj) { const int col = (pn - 12) * 256 + bj * 128 + cw;
                ROWLOOP { ROWDEF const float rsr = rs0[u.ix * 256 + (row & 255)];  *(u32x4*)(XQ + (size_t)row * 512 + col) = pack8((acc[ai][bj][m][0] * rsr) * XSCALE, (acc[ai][bj][m][1] * rsr) * XSCALE);  } }
        } else {
#pragma unroll
            for (int bj = 0; bj < 2; ++bj) { const int col = (pn - 14) * 256 + bj * 128 + cw;
                ROWLOOP { ROWDEF const float rsr = rs0[u.ix * 256 + (row & 255)];  f32x4 a = (acc[ai][bj][m][0] * rsr), b = (acc[ai][bj][m][1] * rsr);
#pragma unroll
                    for (int j = 0; j < 4; ++j) { a[j] = siluf_(a[j]); b[j] = siluf_(b[j]); }
                    *(u32x4*)(XZ + (size_t)row * 512 + col) = pack8(a, b);  } }
        }
    }
};

struct Epi3 {
    static constexpr bool PERM = true, AFTER_DRAIN = false;
    bf16_t *Q, *KB, *VB, *ZS, *XQ, *XZ; float* out; const float* PS; const LAS float* rs_lds;
    DI void operator()(const f32x4 (&acc)[2][2][4][2], const pg8::Unit& u, int wr, int wc, int fr, int fq) const {
        const int row0 = u.pm * 256 + wr * 64 + fr; const int pn = u.pn; const int cw = wc * 32 + 8 * fq;
        if (pn < 5) {
            const int d1 = 16 * (wc & 1) + 4 * fq;
            float invrev[4];
#pragma unroll
            for (int j = 0; j < 4; ++j) invrev[j] = __builtin_amdgcn_exp2f(-(float)(d1 + j) * 0.41524101186092033f) * 0.15915494309189535f;
            ROWLOOP { ROWDEF RSRDEF
                const int pos = row < TP ? (row & 16383) : 2048 + ((row - TP) & 63);
                float cs[4], sn[4];
#pragma unroll
                for (int j = 0; j < 4; ++j) { const float rr = __builtin_amdgcn_fractf((float)pos * invrev[j]); cs[j] = __builtin_amdgcn_cosf(rr); sn[j] = __builtin_amdgcn_sinf(rr); }
                if (pn < 4) {
#pragma unroll
                    for (int bj = 0; bj < 2; ++bj) { const int head = pn * 4 + bj * 2 + (wc >> 1);
                        f32x4 x1 = (acc[ai][bj][m][0] * rsr), x2 = (acc[ai][bj][m][1] * rsr), o1, o2;
#pragma unroll
                        for (int j = 0; j < 4; ++j) { o1[j] = (x1[j] * cs[j] - x2[j] * sn[j]) * QSCALE; o2[j] = (x2[j] * cs[j] + x1[j] * sn[j]) * QSCALE; }
                        bf16_t* qp = Q + (size_t)row * DM + head * 64 + d1;
                        u32x2 w1, w2; w1.x = pk2(o1[0], o1[1]); w1.y = pk2(o1[2], o1[3]); w2.x = pk2(o2[0], o2[1]); w2.y = pk2(o2[2], o2[3]);
                        *(u32x2*)qp = w1; *(u32x2*)(qp + 32) = w2; }
                } else {
                    float* kc = nullptr; float* vc = nullptr;
                    if (row < TP) { const int t = row & 16383; if (t >= 16256) { const size_t o = ((size_t)((row >> 14) * 128 + (t - 16256))) * 128; kc = out + O_KP + o; vc = out + O_VP + o; } }
                    else { const int r2 = row - TP; const size_t o = ((size_t)((r2 >> 6) * 128 + 64 + (r2 & 63))) * 128; kc = out + O_KS + o; vc = out + O_VS + o; }
                    { const int kvh = wc >> 1;
                        f32x4 x1 = (acc[ai][0][m][0] * rsr), x2 = (acc[ai][0][m][1] * rsr), o1, o2;
#pragma unroll
                        for (int j = 0; j < 4; ++j) { o1[j] = x1[j] * cs[j] - x2[j] * sn[j]; o2[j] = x2[j] * cs[j] + x1[j] * sn[j]; }
                        bf16_t* kp = KB + (size_t)row * 128 + kvh * 64 + d1;
                        u32x2 w1, w2; w1.x = pk2(o1[0], o1[1]); w1.y = pk2(o1[2], o1[3]); w2.x = pk2(o2[0], o2[1]); w2.y = pk2(o2[2], o2[3]);
                        *(u32x2*)kp = w1; *(u32x2*)(kp + 32) = w2;
                        if (kc) { *(f32x4*)(kc + kvh * 64 + d1) = o1; *(f32x4*)(kc + kvh * 64 + d1 + 32) = o2; } }
                    { f32x4 a = (acc[ai][1][m][0] * rsr), b = (acc[ai][1][m][1] * rsr);
                        *(u32x4*)(VB + (size_t)row * 128 + cw) = pack8(a, b);
                        if (vc) { *(f32x4*)(vc + cw) = a; *(f32x4*)(vc + cw + 4) = b; } }
                }
             }
        } else if (pn < 9) {
            ROWLOOP { ROWDEF RSRDEF
#pragma unroll
                for (int bj = 0; bj < 2; ++bj) { const int col = (pn - 5) * 256 + bj * 128 + cw;
                    f32x4 a = (acc[ai][bj][m][0] * rsr), b = (acc[ai][bj][m][1] * rsr);
#pragma unroll
                    for (int j = 0; j < 4; ++j) { a[j] = siluf_(a[j]); b[j] = siluf_(b[j]); }
                    *(u32x4*)(ZS + (size_t)row * DM + col) = pack8(a, b); } }
        } else if (pn < 11) {
            ROWLOOP { ROWDEF RSRDEF
#pragma unroll
                for (int bj = 0; bj < 2; ++bj) { const int col = (pn - 9) * 256 + bj * 128 + cw;
                    *(u32x4*)(XQ + (size_t)row * 512 + col) = pack8((acc[ai][bj][m][0] * rsr) * XSCALE, (acc[ai][bj][m][1] * rsr) * XSCALE); } }
        } else {
            ROWLOOP { ROWDEF RSRDEF
#pragma unroll
                for (int bj = 0; bj < 2; ++bj) { const int col = (pn - 11) * 256 + bj * 128 + cw;
                    f32x4 a = (acc[ai][bj][m][0] * rsr), b = (acc[ai][bj][m][1] * rsr);
#pragma unroll
                    for (int j = 0; j < 4; ++j) { a[j] = siluf_(a[j]); b[j] = siluf_(b[j]); }
                    *(u32x4*)(XZ + (size_t)row * 512 + col) = pack8(a, b); } }
        }
    }
};

struct Epi2 {
    static constexpr bool PERM = true, AFTER_DRAIN = false;
    const bf16_t* XB; bf16_t* X2;
    DI void operator()(const f32x4 (&acc)[2][2][4][2], const pg8::Unit& u, int wr, int wc, int fr, int fq) const {
        const int row0 = u.pm * 256 + wr * 64 + fr; const int cw = u.pn * 256 + wc * 32 + 8 * fq;
        ROWLOOP { ROWDEF
#pragma unroll
            for (int bj = 0; bj < 2; ++bj) { const size_t o = (size_t)row * DM + cw + bj * 128;
                const u32x4 r = *(const u32x4*)(XB + o);
                const f32x4 v0 = (f32x4){bflo(r.x), bfhi(r.x), bflo(r.y), bfhi(r.y)} + acc[ai][bj][m][0], v1 = (f32x4){bflo(r.z), bfhi(r.z), bflo(r.w), bfhi(r.w)} + acc[ai][bj][m][1];
                *(u32x4*)(X2 + o) = pack8(v0, v1); }
        }
    }
};

struct SplitOrder {
    int c;
    __device__ bool next(int i, pg8::Unit& u) const { if (i > 0 || c >= 64) return false; u.pm = 128 + (c >> 4); u.pn = (c >> 2) & 3; u.ko = (c & 3) * 384; u.ix = 0; return true; }
    DI void a_ready(const pg8::Unit&) const {}
    DI void done(const pg8::Unit&) const {}
};
struct OneTile {
    int pm, pn;
    __device__ bool next(int i, pg8::Unit& u) const { if (i > 0) return false; u.pm = pm; u.pn = pn; u.ko = 0; u.ix = 0; return true; }
    DI void a_ready(const pg8::Unit&) const {}
    DI void done(const pg8::Unit&) const {}
};
struct Order3 {
    int G, c;
    __device__ bool next(int i, pg8::Unit& u) const {
        const int L = i * G + c; if (L >= 1536) return false;
        const int wgid = (L & 7) * 192 + (L >> 3);
        if (wgid < 1248) { const int gid = wgid / 104, w = wgid % 104; u.pm = gid * 8 + (w & 7); u.pn = w >> 3; }
        else { const int w2 = wgid - 1248, gid = w2 / 72, w = w2 % 72; u.pm = 96 + gid * 8 + (w & 7); u.pn = w >> 3; }
        u.ko = 0; u.ix = i; return true;
    }
    DI void a_ready(const pg8::Unit&) const {}
    DI void done(const pg8::Unit&) const {}
};
struct EpiPart {
    static constexpr bool PERM = true, AFTER_DRAIN = false;
    float* part;
    DI void operator()(const f32x4 (&acc)[2][2][4][2], const pg8::Unit& u, int wr, int wc, int fr, int fq) const {
        const int row0 = (u.pm - 128) * 256 + wr * 64 + fr; const int cw = u.pn * 256 + wc * 32 + 8 * fq;
        float* base = part + (size_t)(u.ko / 384) * (TSMP * DM);
        ROWLOOP { ROWDEF
            float* dst = base + (size_t)row * DM;
#pragma unroll
            for (int bj = 0; bj < 2; ++bj) { *(f32x4*)(dst + cw + bj * 128) = acc[ai][bj][m][0]; *(f32x4*)(dst + cw + bj * 128 + 4) = acc[ai][bj][m][1]; }
        }
    }
};
struct Epi2a {
    static constexpr bool PERM = true, AFTER_DRAIN = false;
    bf16_t* XB; float* PS;
    DI void operator()(const f32x4 (&acc)[2][2][4][2], const pg8::Unit& u, int wr, int wc, int fr, int fq) const {
        const int row0 = u.pm * 256 + wr * 64 + fr; const int cw = u.pn * 256 + wc * 32 + 8 * fq;
        ROWLOOP { ROWDEF
            bf16_t* xb = XB + (size_t)row * DM;
            float ss = 0.f;
#pragma unroll
            for (int bj = 0; bj < 2; ++bj) { const int col = cw + bj * 128;
                const u32x4 r = *(const u32x4*)(xb + col);
                const f32x4 v0 = (f32x4){bflo(r.x), bfhi(r.x), bflo(r.y), bfhi(r.y)} + acc[ai][bj][m][0], v1 = (f32x4){bflo(r.z), bfhi(r.z), bflo(r.w), bfhi(r.w)} + acc[ai][bj][m][1];
                *(u32x4*)(xb + col) = pack8(v0, v1);
                ss += (v0[0] * v0[0] + v0[1] * v0[1]) + (v0[2] * v0[2] + v0[3] * v0[3]) + (v1[0] * v1[0] + v1[1] * v1[1]) + (v1[2] * v1[2] + v1[3] * v1[3]); }
            ss += __shfl_xor(ss, 16); ss += __shfl_xor(ss, 32);
            if (fq == 0) PS[(size_t)row * 16 + u.pn * 4 + wc] = ss;
        }
    }
};
struct EpiM {
    static constexpr bool PERM = true, AFTER_DRAIN = false;
    bf16_t *MK, *MV; float* out;
    DI void operator()(const f32x4 (&acc)[2][2][4][2], const pg8::Unit& u, int wr, int wc, int fr, int fq) const {
        const int row0 = u.pm * 256 + wr * 64 + fr;
#pragma unroll
        for (int bj = 0; bj < 2; ++bj) { const int c = u.pn * 256 + bj * 128 + wc * 32 + 8 * fq; const int layer = c >> 10, e = c & 1023, isv = e >> 9, e2 = e & 511;
            ROWLOOP { ROWDEF  const size_t o = ((size_t)((layer * 2 + (row >> 8)) * 256 + (row & 255))) * 512 + e2;
                float* fo = out + (isv ? O_MVP : O_MKP) + o; bf16_t* bo = (isv ? MV : MK) + o;
                *(f32x4*)fo = acc[ai][bj][m][0]; *(f32x4*)(fo + 4) = acc[ai][bj][m][1];
                *(u32x4*)bo = pack8(acc[ai][bj][m][0], acc[ai][bj][m][1]);  } }
    }
};

DI int map_conv(int n) { if (n < 2048) { const int ch = n & 1023; return ((ch >> 7) << 8) + ((n >> 10) << 7) + (ch & 127); } return n; }
DI int ropepos(int d) { return 32 * ((d & 31) >> 4) + 8 * ((d >> 2) & 3) + 4 * (d >> 5) + (d & 3); }
DI int map_attn(int n) { if (n < 1152) return (n & ~63) + ropepos(n & 63); return n; }
template <int MAP> DI void transpose_item(const float* W, int K, int N, bf16_t* WT, LAS float* scr, int item, int lane, const float* gain = nullptr) {
    const int nblk = N / 32, kb = item / nblk, nb = item % nblk, k0 = 64 * kb, n0 = 32 * nb;
    float tv[32];
#pragma unroll
    for (int i = 0; i < 32; ++i) tv[i] = W[(size_t)(k0 + 2 * i + (lane >> 5)) * N + n0 + (lane & 31)];
#pragma unroll
    for (int i = 0; i < 32; ++i) scr[(2 * i + (lane >> 5)) * 33 + (lane & 31)] = tv[i];
    asm volatile("s_waitcnt lgkmcnt(0)" ::: "memory");
    const int c = lane & 7;
#pragma unroll
    for (int j = 0; j < 4; ++j) { const int n = (lane >> 3) + 8 * j; const LAS float* s = scr + (8 * c) * 33 + n;
        f32x4 g0 = {1.f, 1.f, 1.f, 1.f}, g1 = g0; if (gain) { g0 = *(const f32x4*)(gain + k0 + 8 * c); g1 = *(const f32x4*)(gain + k0 + 8 * c + 4); }
        u32x4 o; o.x = pk2(s[0 * 33] * g0[0], s[1 * 33] * g0[1]); o.y = pk2(s[2 * 33] * g0[2], s[3 * 33] * g0[3]); o.z = pk2(s[4 * 33] * g1[0], s[5 * 33] * g1[1]); o.w = pk2(s[6 * 33] * g1[2], s[7 * 33] * g1[3]);
        const int nn = n0 + n; const int dr = MAP == 1 ? map_conv(nn) : (MAP == 2 ? map_attn(nn) : nn);
        *(u32x4*)(WT + (size_t)dr * K + k0 + 8 * c) = o; }
    asm volatile("s_waitcnt lgkmcnt(0)" ::: "memory");
}
DI void rms_row_bf16(const float* xrow, const float* g, bf16_t* orow, int lane) {
    const f32x4* xr = (const f32x4*)xrow + lane; const f32x4* gr = (const f32x4*)g + lane;
    f32x4 v[4]; float s = 0.f;
#pragma unroll
    for (int j = 0; j < 4; ++j) { v[j] = xr[64 * j]; s += (v[j].x * v[j].x + v[j].y * v[j].y) + (v[j].z * v[j].z + v[j].w * v[j].w); }
    const float rstd = 1.0f / sqrtf(wave_sum(s) * (1.f / DM) + 1e-6f);
    u32x2* o8 = (u32x2*)orow + lane;
#pragma unroll
    for (int j = 0; j < 4; ++j) { const f32x4 gg = gr[64 * j]; u32x2 w; w.x = pk2(v[j].x * rstd * gg.x, v[j].y * rstd * gg.y); w.y = pk2(v[j].z * rstd * gg.z, v[j].w * rstd * gg.w); o8[64 * j] = w; }
}
DI void rms_row_final(const bf16_t* xrow, float* orow, const float* g, int lane, const float* part) {
    const u32x2* xr = (const u32x2*)xrow + lane; const f32x4* gr = (const f32x4*)g + lane; f32x4* o4 = (f32x4*)orow + lane;
    f32x4 v[4]; float s = 0.f;
#pragma unroll
    for (int j = 0; j < 4; ++j) { const u32x2 r = xr[64 * j]; v[j] = (f32x4){bflo(r.x), bfhi(r.x), bflo(r.y), bfhi(r.y)};
        if (part) {
#pragma unroll
            for (int ks = 0; ks < 4; ++ks) v[j] += ((const f32x4*)(part + (size_t)ks * TSMP * DM) + lane)[64 * j]; }
        s += (v[j].x * v[j].x + v[j].y * v[j].y) + (v[j].z * v[j].z + v[j].w * v[j].w); }
    const float rstd = 1.0f / sqrtf(wave_sum(s) * (1.f / DM) + 1e-6f);
#pragma unroll
    for (int j = 0; j < 4; ++j) { const f32x4 gg = gr[64 * j]; o4[64 * j] = v[j] * rstd * gg; }
}

template <int R> DI void rms_rows_bf16(const float* xp, const float* xs, int m0, int stride, float* PS0, bf16_t* H, int lane) {
    f32x4 v[R][4];
#pragma unroll
    for (int k = 0; k < R; ++k) { const int mm = m0 + k * stride; const f32x4* xr = (const f32x4*)(mm < TP ? xp + (size_t)mm * DM : xs + (size_t)(mm - TP) * DM) + lane;
#pragma unroll
        for (int j = 0; j < 4; ++j) v[k][j] = xr[64 * j]; }
#pragma unroll
    for (int k = 0; k < R; ++k) { float s = 0.f;
#pragma unroll
        for (int j = 0; j < 4; ++j) s += (v[k][j].x * v[k][j].x + v[k][j].y * v[k][j].y) + (v[k][j].z * v[k][j].z + v[k][j].w * v[k][j].w);
        s = wave_sum(s);
        if (lane == 0) PS0[m0 + k * stride] = s;
        u32x2* o8 = (u32x2*)(H + (size_t)(m0 + k * stride) * DM) + lane;
#pragma unroll
        for (int j = 0; j < 4; ++j) { u32x2 w; w.x = pk2(v[k][j].x, v[k][j].y); w.y = pk2(v[k][j].z, v[k][j].w); o8[64 * j] = w; } }
}
template <int R> DI void rms_rows_final(const bf16_t* X2, float* out, int m0, int stride, const float* g, int lane) {
    u32x2 rr[R][4];
#pragma unroll
    for (int k = 0; k < R; ++k) { const u32x2* xr = (const u32x2*)(X2 + (size_t)(m0 + k * stride) * DM) + lane;
#pragma unroll
        for (int j = 0; j < 4; ++j) rr[k][j] = xr[64 * j]; }
    f32x4 gg[4];
#pragma unroll
    for (int j = 0; j < 4; ++j) gg[j] = ((const f32x4*)g + lane)[64 * j];
#pragma unroll
    for (int k = 0; k < R; ++k) { f32x4 v[4]; float s = 0.f;
#pragma unroll
        for (int j = 0; j < 4; ++j) { v[j] = (f32x4){bflo(rr[k][j].x), bfhi(rr[k][j].x), bflo(rr[k][j].y), bfhi(rr[k][j].y)}; s += (v[j].x * v[j].x + v[j].y * v[j].y) + (v[j].z * v[j].z + v[j].w * v[j].w); }
        const float rstd = 1.0f / sqrtf(wave_sum(s) * (1.f / DM) + 1e-6f);
        f32x4* o4 = (f32x4*)(out + (size_t)(m0 + k * stride) * DM) + lane;
#pragma unroll
        for (int j = 0; j < 4; ++j) o4[64 * j] = v[j] * rstd * gg[j]; }
}

DI void prologue(const Args& a, LAS unsigned char* lds, int G) {
    const int tid = threadIdx.x, lane = tid & 63, wave = __builtin_amdgcn_readfirstlane(tid >> 6);
    LAS float* scr = (LAS float*)(lds + wave * 16384);
    const int gw = blockIdx.x * 8 + wave, NGW = G * 8;
    unsigned char* ws = a.ws;
    constexpr int I_C = 16 * 128, I_A = 16 * 104, I_O = 24 * 32, I_M = 16 * 32;
    constexpr int NITEMS = I_C + I_A + 2 * I_O + 2 * I_M;
    for (int it = gw; it < NITEMS; it += NGW) {
        int r = it;
        if (r < I_C) { transpose_item<1>(a.in[9], 1024, 4096, (bf16_t*)(ws + WS_WC), scr, r, lane, a.in[8]); continue; } r -= I_C;
        if (r < I_A) { transpose_item<2>(a.in[14], 1024, 3328, (bf16_t*)(ws + WS_WA), scr, r, lane, a.in[8] + DM); continue; } r -= I_A;
        if (r < 2 * I_O) { const int l = r / I_O; transpose_item<0>(a.in[17] + (size_t)l * 1536 * 1024, 1536, 1024, (bf16_t*)(ws + WS_WO) + (size_t)l * 1024 * 1536, scr, r % I_O, lane); continue; } r -= 2 * I_O;
        { const int l = r / I_M; transpose_item<0>(a.in[16] + (size_t)l * 1024 * 1024, 1024, 1024, (bf16_t*)(ws + WS_WM) + (size_t)l * 1024 * 1024, scr, r % I_M, lane); }
    }
    bf16_t* H = (bf16_t*)(ws + WS_H);
    { int m = gw;
      for (; m + 3 * NGW < TT; m += 4 * NGW) rms_rows_bf16<4>(a.in[0], a.in[1], m, NGW, (float*)(ws + WS_PS0), H, lane);
      for (; m < TT; m += NGW) rms_rows_bf16<1>(a.in[0], a.in[1], m, NGW, (float*)(ws + WS_PS0), H, lane); }
    const int gt = blockIdx.x * NTHR + tid, NGT = G * NTHR;
    { bf16_t* MP = (bf16_t*)(ws + WS_MP); for (int i = gt; i < 512 * 1024 / 8; i += NGT) *(u32x4*)(MP + (size_t)i * 8) = pack8f(a.in[7] + (size_t)i * 8); }
    for (int i = gt; i < 2 * 16 * 2048; i += NGT) { const int which = i >> 15, r = i & 32767, b = r >> 11, o = r & 2047;
        const f32x4 v = *(const f32x4*)(a.in[3 + which] + (size_t)(b * 128 + 64) * 128 + o * 4);
        *(f32x4*)(a.out + (which ? O_VS : O_KS) + (size_t)(b * 128) * 128 + o * 4) = v; }
}

#define MFMA32(a, b, c) __builtin_amdgcn_mfma_f32_32x32x16_bf16((a), (b), (c), 0, 0, 0)
typedef short v4i16_t __attribute__((ext_vector_type(4)));
DI s16x4 v_tr(const LAS unsigned char* p) { return __builtin_bit_cast(s16x4, __builtin_amdgcn_ds_read_tr16_b64_v4i16((LAS v4i16_t*)p)); }
DI int v_lane_off(int r, int h) { const int lane = r + 32 * h; return ((lane >> 4) & 1) * 32 + (lane & 3) * 8 + (4 * h + ((lane & 15) >> 2)) * 64; }
template <int NKT, int NDS, int NDT, int KSTR, int VSTR, bool SINK>
DI void attn_core(const LAS unsigned char* Kl, const LAS unsigned char* Vl, const bf16x8 (&qf)[NDS], int kt0, float sink, f32x16 (&o)[NDT], float& rl, int r, int h) {
    f32x16 s[NKT];
#pragma unroll
    for (int kt = 0; kt < NKT; ++kt) {
        if (kt >= kt0) {
#pragma unroll
            for (int i = 0; i < 16; ++i) s[kt][i] = 0.f;
#pragma unroll
            for (int ds = 0; ds < NDS; ++ds) { const bf16x8 ka = *(const LAS bf16x8*)(Kl + (kt * 32 + r) * KSTR + ds * 32 + h * 16); s[kt] = MFMA32(ka, qf[ds], s[kt]); }
        } else {
#pragma unroll
            for (int i = 0; i < 16; ++i) s[kt][i] = -INFINITY;
        }
    }
    float m = -INFINITY;
#pragma unroll
    for (int kt = 0; kt < NKT; ++kt)
#pragma unroll
        for (int i = 0; i < 16; ++i) m = fmaxf(m, s[kt][i]);
    m = fmaxf(m, __shfl_xor(m, 32));
    if (SINK) m = fmaxf(m, sink);
    float l = 0.f;
#pragma unroll
    for (int kt = 0; kt < NKT; ++kt)
#pragma unroll
        for (int i = 0; i < 16; ++i) { s[kt][i] = __builtin_amdgcn_exp2f(s[kt][i] - m); l += s[kt][i]; }
    l += __shfl_xor(l, 32);
    if (SINK) l += __builtin_amdgcn_exp2f(sink - m);
    rl = 1.0f / l;
#pragma unroll
    for (int dt = 0; dt < NDT; ++dt)
#pragma unroll
        for (int i = 0; i < 16; ++i) o[dt][i] = 0.f;
#pragma unroll
    for (int kt = 0; kt < NKT; ++kt) {
        if (kt >= kt0) {
#pragma unroll
            for (int st = 0; st < 2; ++st) {
                u32x4 pw; pw.x = pk2(s[kt][8 * st + 0], s[kt][8 * st + 1]); pw.y = pk2(s[kt][8 * st + 2], s[kt][8 * st + 3]); pw.z = pk2(s[kt][8 * st + 4], s[kt][8 * st + 5]); pw.w = pk2(s[kt][8 * st + 6], s[kt][8 * st + 7]);
                const bf16x8 pb = __builtin_bit_cast(bf16x8, pw);
#pragma unroll
                for (int dt = 0; dt < NDT; ++dt) {
                    const LAS unsigned char* vp = Vl + dt * VSTR + (kt * 32 + 16 * st) * 64 + v_lane_off(r, h);
                    const s16x4 lo = v_tr(vp), hi = v_tr(vp + 512);
                    const bf16x8 va = __builtin_shufflevector(lo, hi, 0, 1, 2, 3, 4, 5, 6, 7);
                    o[dt] = MFMA32(va, pb, o[dt]);
                }
            }
        }
    }
}
template <int NDS, int KSTR> DI void ld_kfrag(bf16x8 (&ka)[NDS], const LAS unsigned char* Kl, int kt, int r, int h) {
#pragma unroll
    for (int ds = 0; ds < NDS; ++ds) ka[ds] = *(const LAS bf16x8*)(Kl + (kt * 32 + r) * KSTR + ds * 32 + h * 16);
}
template <int NKT, int NDS, int NDT, int KSTR, int VSTR, bool SINK>
DI void attn_core3(const LAS unsigned char* Kl, const LAS unsigned char* Vl, const bf16x8 (&qf)[NDS], int kt0, float sink, f32x16 (&o)[NDT], float& rl, int r, int h) {
    float m = -INFINITY;
    const int ktb = SINK ? kt0 : 0;
    bf16x8 ka[NDS];
    ld_kfrag<NDS, KSTR>(ka, Kl, ktb, r, h);
#pragma unroll
    for (int kt = 0; kt < NKT; ++kt) {
        if (!SINK || kt >= kt0) {
            f32x16 s;
#pragma unroll
            for (int i = 0; i < 16; ++i) s[i] = 0.f;
#pragma unroll
            for (int ds = 0; ds < NDS; ++ds) s = MFMA32(ka[ds], qf[ds], s);
            asm volatile("" ::: "memory");
            if (kt + 1 < NKT) ld_kfrag<NDS, KSTR>(ka, Kl, kt + 1, r, h);
#pragma unroll
            for (int i = 0; i < 16; ++i) m = fmaxf(m, s[i]);
            asm volatile("" ::: "memory");
        }
    }
    m = fmaxf(m, __shfl_xor(m, 32));
    if (SINK) m = fmaxf(m, sink);
    asm volatile("" : "+v"(m) :: "memory");
    float l = 0.f;
#pragma unroll
    for (int dt = 0; dt < NDT; ++dt)
#pragma unroll
        for (int i = 0; i < 16; ++i) o[dt][i] = 0.f;
    ld_kfrag<NDS, KSTR>(ka, Kl, ktb, r, h);
#pragma unroll
    for (int kt = 0; kt < NKT; ++kt) {
        if (!SINK || kt >= kt0) {
            bf16x8 va[2][NDT];
#pragma unroll
            for (int st = 0; st < 2; ++st)
#pragma unroll
                for (int dt = 0; dt < NDT; ++dt) {
                    const LAS unsigned char* vp = Vl + dt * VSTR + (kt * 32 + 16 * st) * 64 + v_lane_off(r, h);
                    const s16x4 lo = v_tr(vp), hi = v_tr(vp + 512);
                    va[st][dt] = __builtin_shufflevector(lo, hi, 0, 1, 2, 3, 4, 5, 6, 7); }
            f32x16 s;
#pragma unroll
            for (int i = 0; i < 16; ++i) s[i] = -m;
#pragma unroll
            for (int ds = 0; ds < NDS; ++ds) s = MFMA32(ka[ds], qf[ds], s);
            asm volatile("" ::: "memory");
            if (kt + 1 < NKT) ld_kfrag<NDS, KSTR>(ka, Kl, kt + 1, r, h);
#pragma unroll
            for (int i = 0; i < 16; ++i) { s[i] = __builtin_amdgcn_exp2f(s[i]); l += s[i]; }
#pragma unroll
            for (int st = 0; st < 2; ++st) {
                u32x4 pw; pw.x = pk2(s[8 * st + 0], s[8 * st + 1]); pw.y = pk2(s[8 * st + 2], s[8 * st + 3]); pw.z = pk2(s[8 * st + 4], s[8 * st + 5]); pw.w = pk2(s[8 * st + 6], s[8 * st + 7]);
                const bf16x8 pb = __builtin_bit_cast(bf16x8, pw);
#pragma unroll
                for (int dt = 0; dt < NDT; ++dt) o[dt] = MFMA32(va[st][dt], pb, o[dt]);
            }
            asm volatile("" ::: "memory");
        }
    }
    l += __shfl_xor(l, 32);
    if (SINK) l += __builtin_amdgcn_exp2f(sink - m);
    rl = 1.0f / l;
}
template <int NKT, int NDS, int NDT, int KSTR, int VSTR, bool SINK>
DI void attn_core2(const LAS unsigned char* Kl, const LAS unsigned char* Vl, const bf16x8 (&qf)[NDS], int kt0, float sink, f32x16 (&o)[NDT], float& rl, int r, int h) {
    float m = -INFINITY;
#pragma unroll
    for (int kt = 0; kt < NKT; ++kt) {
        if (SINK && kt < kt0) continue;
        f32x16 s;
#pragma unroll
        for (int i = 0; i < 16; ++i) s[i] = 0.f;
#pragma unroll
        for (int ds = 0; ds < NDS; ++ds) { const bf16x8 ka = *(const LAS bf16x8*)(Kl + (kt * 32 + r) * KSTR + ds * 32 + h * 16); s = MFMA32(ka, qf[ds], s); }
#pragma unroll
        for (int i = 0; i < 16; ++i) m = fmaxf(m, s[i]);
    }
    m = fmaxf(m, __shfl_xor(m, 32));
    if (SINK) m = fmaxf(m, sink);
    asm volatile("" : "+v"(m) :: "memory");
    float l = 0.f;
#pragma unroll
    for (int dt = 0; dt < NDT; ++dt)
#pragma unroll
        for (int i = 0; i < 16; ++i) o[dt][i] = 0.f;
#pragma unroll
    for (int kt = 0; kt < NKT; ++kt) {
        if (SINK && kt < kt0) continue;
        f32x16 s;
#pragma unroll
        for (int i = 0; i < 16; ++i) s[i] = -m;
#pragma unroll
        for (int ds = 0; ds < NDS; ++ds) { const bf16x8 ka = *(const LAS bf16x8*)(Kl + (kt * 32 + r) * KSTR + ds * 32 + h * 16); s = MFMA32(ka, qf[ds], s); }
#pragma unroll
        for (int i = 0; i < 16; ++i) { s[i] = __builtin_amdgcn_exp2f(s[i]); l += s[i]; }
#pragma unroll
        for (int st = 0; st < 2; ++st) {
            u32x4 pw; pw.x = pk2(s[8 * st + 0], s[8 * st + 1]); pw.y = pk2(s[8 * st + 2], s[8 * st + 3]); pw.z = pk2(s[8 * st + 4], s[8 * st + 5]); pw.w = pk2(s[8 * st + 6], s[8 * st + 7]);
            const bf16x8 pb = __builtin_bit_cast(bf16x8, pw);
#pragma unroll
            for (int dt = 0; dt < NDT; ++dt) {
                const LAS unsigned char* vp = Vl + dt * VSTR + (kt * 32 + 16 * st) * 64 + v_lane_off(r, h);
                const s16x4 lo = v_tr(vp), hi = v_tr(vp + 512);
                const bf16x8 va = __builtin_shufflevector(lo, hi, 0, 1, 2, 3, 4, 5, 6, 7);
                o[dt] = MFMA32(va, pb, o[dt]);
            }
        }
        asm volatile("" ::: "memory");
    }
    l += __shfl_xor(l, 32);
    if (SINK) l += __builtin_amdgcn_exp2f(sink - m);
    rl = 1.0f / l;
}
DI void vt_write8(LAS unsigned char* Vl, int vstr, int d0, int key, u32x4 v) {
    LAS unsigned short* p = (LAS unsigned short*)(Vl + d0 * vstr + key * 2); const int st = vstr / 2;
    p[0 * st] = (unsigned short)(v.x & 0xffff); p[1 * st] = (unsigned short)(v.x >> 16); p[2 * st] = (unsigned short)(v.y & 0xffff); p[3 * st] = (unsigned short)(v.y >> 16);
    p[4 * st] = (unsigned short)(v.z & 0xffff); p[5 * st] = (unsigned short)(v.z >> 16); p[6 * st] = (unsigned short)(v.w & 0xffff); p[7 * st] = (unsigned short)(v.w >> 16);
}

constexpr int MEM_KSTR = 272, MEM_VSTR = 256 * 64, MEM_VOFF = 256 * MEM_KSTR;
DI void memattn_unit(const Args& a, LAS unsigned char* lds, int layer, int unit) {
    const int tid = threadIdx.x, lane = tid & 63, w = __builtin_amdgcn_readfirstlane(tid >> 6), r = lane & 31, h = lane >> 5;
    unsigned char* ws = a.ws;
    int b, hd, tok0, ntok; bool sample;
    if (unit < 512) { b = unit >> 8; hd = (unit >> 6) & 3; tok0 = b * 16384 + (unit & 63) * 256; ntok = 256; sample = false; }
    else { const int s = unit - 512; b = s >> 2; hd = s & 3; tok0 = TP + b * 64; ntok = 64; sample = true; }
    LAS unsigned char* Kl = lds; LAS unsigned char* Vl = lds + MEM_VOFF;
    const bool act = w * 32 < ntok;
    const bf16_t* XZ = (const bf16_t*)(ws + WS_XZ); bf16_t* A2 = (bf16_t*)(ws + WS_A2);
    bf16x8 qf[8]; u32x4 zv[8];
    if (!sample) {
        const bf16_t* Kg = (const bf16_t*)(ws + WS_MK) + ((size_t)(layer * 2 + b) * 256) * 512 + hd * 128;
        const bf16_t* Vg = (const bf16_t*)(ws + WS_MV) + ((size_t)(layer * 2 + b) * 256) * 512 + hd * 128;
        u32x4 kk[8], vv[8];
#pragma unroll
        for (int it = 0; it < 8; ++it) { const int ci = tid + NTHR * it;
            kk[it] = *(const u32x4*)(Kg + (size_t)(ci >> 4) * 512 + (ci & 15) * 8);
            vv[it] = *(const u32x4*)(Vg + (size_t)(ci >> 4) * 512 + (ci & 15) * 8); }
        { const bf16_t* qp = (const bf16_t*)(ws + WS_XQ) + ((size_t)tok0 + w * 32 + r) * 512 + hd * 128 + h * 8;
#pragma unroll
            for (int ds = 0; ds < 8; ++ds) qf[ds] = *(const bf16x8*)(qp + ds * 16); }
#pragma unroll
        for (int it = 0; it < 8; ++it) { const int ci = tid + NTHR * it;
            *(LAS u32x4*)(Kl + (ci >> 4) * MEM_KSTR + (ci & 15) * 16) = kk[it];
            *(LAS u32x4*)(Vl + ((ci & 15) >> 2) * MEM_VSTR + (ci >> 4) * 64 + (ci & 3) * 16) = vv[it]; }
    } else {
        const float* Kg = a.in[5] + ((size_t)(layer * 16 + b) * 256) * 512 + hd * 128;
        const float* Vg = a.in[6] + ((size_t)(layer * 16 + b) * 256) * 512 + hd * 128;
        if (act) { const bf16_t* qp = (const bf16_t*)(ws + WS_XQ) + ((size_t)tok0 + w * 32 + r) * 512 + hd * 128 + h * 8;
#pragma unroll
            for (int ds = 0; ds < 8; ++ds) qf[ds] = *(const bf16x8*)(qp + ds * 16); }
#pragma unroll 4
        for (int it = 0; it < 8; ++it) { const int ci = tid + NTHR * it;
            { const int key = ci >> 4, c8 = ci & 15; *(LAS u32x4*)(Kl + key * MEM_KSTR + c8 * 16) = pack8f(Kg + (size_t)key * 512 + c8 * 8); }
            { const int key = ci >> 4, c8 = ci & 15; *(LAS u32x4*)(Vl + (c8 >> 2) * MEM_VSTR + key * 64 + (c8 & 3) * 16) = pack8f(Vg + (size_t)key * 512 + c8 * 8); } }
    }
    __syncthreads();
    u32x2 ost[16];
    if (act) {
        f32x16 o[4]; float rl;
        attn_core2<8, 8, 4, MEM_KSTR, MEM_VSTR, false>(Kl, Vl, qf, 0, 0.f, o, rl, r, h);
#pragma unroll
        for (int i = 0; i < 8; ++i) zv[i] = *(const u32x4*)(XZ + ((size_t)tok0 + w * 32 + i * 4 + (lane >> 4)) * 512 + hd * 128 + (lane & 15) * 8);
#pragma unroll
        for (int dt = 0; dt < 4; ++dt)
#pragma unroll
            for (int g = 0; g < 4; ++g) { ost[dt * 4 + g].x = pk2(o[dt][4 * g + 0] * rl, o[dt][4 * g + 1] * rl); ost[dt * 4 + g].y = pk2(o[dt][4 * g + 2] * rl, o[dt][4 * g + 3] * rl); }
    }
    __syncthreads();
    if (act) {
        LAS unsigned char* stg = lds + w * (32 * MEM_KSTR);
#pragma unroll
        for (int dt = 0; dt < 4; ++dt)
#pragma unroll
            for (int g = 0; g < 4; ++g) *(LAS u32x2*)(stg + r * MEM_KSTR + (dt * 32 + 8 * g + 4 * h) * 2) = ost[dt * 4 + g];
#pragma unroll
        for (int i = 0; i < 8; ++i) { const int row = i * 4 + (lane >> 4), ch = lane & 15; const size_t tk = (size_t)tok0 + w * 32 + row;
            const u32x4 ov = *(const LAS u32x4*)(stg + row * MEM_KSTR + ch * 16); const u32x4 z4 = zv[i];
            u32x4 rv; rv.x = pk2(bflo(ov.x) * bflo(z4.x), bfhi(ov.x) * bfhi(z4.x)); rv.y = pk2(bflo(ov.y) * bflo(z4.y), bfhi(ov.y) * bfhi(z4.y));
            rv.z = pk2(bflo(ov.z) * bflo(z4.z), bfhi(ov.z) * bfhi(z4.z)); rv.w = pk2(bflo(ov.w) * bflo(z4.w), bfhi(ov.w) * bfhi(z4.w));
            *(u32x4*)(A2 + tk * 1536 + 1024 + hd * 128 + ch * 8) = rv; }
    }
    __syncthreads();
}

constexpr int SWA_KSTR = 144, SWA_VSTR = 192 * 64, SWA_VOFF = 192 * SWA_KSTR, SWA_STG_OFF = 53248;
struct SwaPre { u32x4 kv[3], vv[3]; bf16x8 qf[4]; };
DI void swa_decode(int unit, int& b, int& kvh, int& tok0, int& kt0, bool& sample) {
    if (unit < 1024) { const int k = unit >> 8, cb = unit & 255; b = k >> 1; kvh = k & 1; const int c = (cb & 7) * 32 + (cb >> 3);
        tok0 = b * 16384 + c * 64; kt0 = c >= 2 ? 0 : (2 - c) * 2; sample = false; }
    else { const int s = unit - 1024; b = s >> 1; kvh = s & 1; tok0 = TP + b * 64; kt0 = 0; sample = true; }
}
DI void swa_issue(const Args& a, int unit, SwaPre& P) {
    const int tid = threadIdx.x, lane = tid & 63, w = __builtin_amdgcn_readfirstlane(tid >> 6), r = lane & 31, h = lane >> 5;
    unsigned char* ws = a.ws;
    int b, kvh, tok0, kt0; bool sample; swa_decode(unit, b, kvh, tok0, kt0, sample);
    const bf16_t* KB = (const bf16_t*)(ws + WS_K); const bf16_t* VB = (const bf16_t*)(ws + WS_V);
    if (!sample) {
        const int tmin = b * 16384;
#pragma unroll
        for (int it = 0; it < 3; ++it) { const int ci = tid + NTHR * it;
            { const int key = ci >> 3, c8 = ci & 7; int tk = tok0 - 128 + key; tk = tk < tmin ? tmin : tk; P.kv[it] = *(const u32x4*)(KB + (size_t)tk * 128 + kvh * 64 + c8 * 8); }
            { const int key = ci >> 3, c8 = ci & 7; int tk = tok0 - 128 + key; tk = tk < tmin ? tmin : tk; P.vv[it] = *(const u32x4*)(VB + (size_t)tk * 128 + kvh * 64 + c8 * 8); } }
    } else {
#pragma unroll
        for (int it = 0; it < 3; ++it) { const int ci = tid + NTHR * it;
            { const int key = ci >> 3, c8 = ci & 7;
                if (key < 128) P.kv[it] = pack8f(a.in[3] + ((size_t)(b * 128 + key) * 2 + kvh) * 64 + c8 * 8);
                else P.kv[it] = *(const u32x4*)(KB + (size_t)(tok0 - 128 + key) * 128 + kvh * 64 + c8 * 8); }
            { const int key = ci >> 3, c8 = ci & 7;
                if (key < 128) P.vv[it] = pack8f(a.in[4] + ((size_t)(b * 128 + key) * 2 + kvh) * 64 + c8 * 8);
                else P.vv[it] = *(const u32x4*)(VB + (size_t)(tok0 - 128 + key) * 128 + kvh * 64 + c8 * 8); } }
    }
    const int head = kvh * 8 + w;
    { const bf16_t* qp = (const bf16_t*)(ws + WS_U) + ((size_t)tok0 + r) * DM + head * 64 + h * 8;
#pragma unroll
        for (int ds = 0; ds < 4; ++ds) P.qf[ds] = *(const bf16x8*)(qp + ds * 16); }
}
DI void swa_phase(const Args& a, LAS unsigned char* lds, int first, int stride, int nunits) {
    const int tid = threadIdx.x, lane = tid & 63, w = __builtin_amdgcn_readfirstlane(tid >> 6), r = lane & 31, h = lane >> 5;
    unsigned char* ws = a.ws;
    LAS unsigned char* Kl = lds; LAS unsigned char* Vl = lds + SWA_VOFF;
    const bf16_t* ZS = (const bf16_t*)(ws + WS_Z); bf16_t* A2 = (bf16_t*)(ws + WS_A2);
    if (first >= nunits) return;
    SwaPre P; swa_issue(a, first, P);
#pragma unroll 1
    for (int unit = first; unit < nunits; unit += stride) {
        int b, kvh, tok0, kt0; bool sample; swa_decode(unit, b, kvh, tok0, kt0, sample);
        const int head = kvh * 8 + w;
#pragma unroll
        for (int it = 0; it < 3; ++it) { const int ci = tid + NTHR * it;
            { const int key = ci >> 3, c8 = ci & 7; *(LAS u32x4*)(Kl + key * SWA_KSTR + c8 * 16) = P.kv[it]; }
            { const int key = ci >> 3, c8 = ci & 7; *(LAS u32x4*)(Vl + (c8 >> 2) * SWA_VSTR + key * 64 + (c8 & 3) * 16) = P.vv[it]; } }
        bf16x8 qf[2][4];
#pragma unroll
        for (int ds = 0; ds < 4; ++ds) qf[0][ds] = P.qf[ds];
        __syncthreads();
        if (unit + stride < nunits) swa_issue(a, unit + stride, P);
        { const bf16_t* qp = (const bf16_t*)(ws + WS_U) + ((size_t)tok0 + 32 + r) * DM + head * 64 + h * 8;
#pragma unroll
            for (int ds = 0; ds < 4; ++ds) qf[1][ds] = *(const bf16x8*)(qp + ds * 16); }
        u32x4 zv[2][4];
        const float sink = a.in[15][head] * LOG2E;
#pragma unroll
        for (int qb = 0; qb < 2; ++qb) {
            f32x16 o[2]; float rl;
            attn_core3<6, 4, 2, SWA_KSTR, SWA_VSTR, true>(Kl, Vl, qf[qb], kt0, sink, o, rl, r, h);
#pragma unroll
            for (int i = 0; i < 4; ++i) zv[qb][i] = *(const u32x4*)(ZS + ((size_t)tok0 + qb * 32 + i * 8 + (lane >> 3)) * DM + head * 64 + (lane & 7) * 8);
            LAS unsigned char* stg = lds + SWA_STG_OFF + w * (32 * 144);
#pragma unroll
            for (int dt = 0; dt < 2; ++dt)
#pragma unroll
                for (int g = 0; g < 4; ++g) { u32x2 ov; ov.x = pk2(o[dt][4 * g + 0] * rl, o[dt][4 * g + 1] * rl); ov.y = pk2(o[dt][4 * g + 2] * rl, o[dt][4 * g + 3] * rl);
                    *(LAS u32x2*)(stg + r * 144 + (dt * 32 + 8 * g + 4 * h) * 2) = ov; }
#pragma unroll
            for (int i = 0; i < 4; ++i) { const int row = i * 8 + (lane >> 3), ch = lane & 7; const size_t tk = (size_t)tok0 + qb * 32 + row;
                const u32x4 ov = *(const LAS u32x4*)(stg + row * 144 + ch * 16); const u32x4 z4 = zv[qb][i];
                u32x4 rv; rv.x = pk2(bflo(ov.x) * bflo(z4.x), bfhi(ov.x) * bfhi(z4.x)); rv.y = pk2(bflo(ov.y) * bflo(z4.y), bfhi(ov.y) * bfhi(z4.y));
                rv.z = pk2(bflo(ov.z) * bflo(z4.z), bfhi(ov.z) * bfhi(z4.z)); rv.w = pk2(bflo(ov.w) * bflo(z4.w), bfhi(ov.w) * bfhi(z4.w));
                *(u32x4*)(A2 + tk * 1536 + head * 64 + ch * 8) = rv; }
            asm volatile("" ::: "memory");
        }
        __syncthreads();
    }
}

template <int I> DI void conv_row(f32x2 (&acc)[32], const f32x2 (&wk)[31], const LAS unsigned char* lds, int rb, int tid) {
    const unsigned uv = *(const LAS unsigned*)(lds + ((rb + I) & 63) * 2048 + tid * 4); const f32x2 uf = {bflo(uv), bfhi(uv)};
    constexpr int T0 = I > 30 ? I - 30 : 0, T1 = I < 31 ? I : 31;
#pragma unroll
    for (int t = T0; t <= T1; ++t) acc[t] += wk[I - t] * uf;
    if constexpr ((I & 3) == 3) asm volatile("" ::: "memory");
    if constexpr (I + 1 < 62) conv_row<I + 1>(acc, wk, lds, rb, tid);
}
constexpr int CONV_RED_OFF = 131072, CONV_STAT_OFF = 131072 + 2048;
DI void conv_run(const Args& a, LAS unsigned char* lds, bool sample, int b, int tile0, int ntiles, const f32x2 (&wk)[31], const f32x2 cb, const f32x2 lg, const f32x2 lb) {
    const int tid = threadIdx.x, lane = tid & 63, w = __builtin_amdgcn_readfirstlane(tid >> 6);
    unsigned char* ws = a.ws;
    const int tfirst0 = tile0 * 32; const int tokbase0 = (sample ? TP + b * 64 : b * 16384) + tfirst0;
    const bf16_t* U = (const bf16_t*)(ws + WS_U); const bf16_t* ZS = (const bf16_t*)(ws + WS_Z); bf16_t* A2 = (bf16_t*)(ws + WS_A2);
    const int prow = tid >> 7, pc = tid & 127;
    u32x4 nw[8];
    {
        const bf16_t* np = U + (size_t)(tokbase0 + prow) * DM + pc * 8;
#pragma unroll
        for (int it = 0; it < 8; ++it) nw[it] = *(const u32x4*)(np + (size_t)it * 4 * DM);
        if (tfirst0 >= 32) {
            const bf16_t* hp = U + (size_t)(tokbase0 - 30 + prow) * DM + pc * 8; u32x4 hv[8];
#pragma unroll
            for (int it = 0; it < 7; ++it) hv[it] = *(const u32x4*)(hp + (size_t)it * 4 * DM);
            if (prow < 2) hv[7] = *(const u32x4*)(hp + (size_t)7 * 4 * DM);
#pragma unroll
            for (int it = 0; it < 7; ++it) *(LAS u32x4*)(lds + (it * 4 + prow) * 2048 + pc * 16) = hv[it];
            if (prow < 2) *(LAS u32x4*)(lds + (28 + prow) * 2048 + pc * 16) = hv[7];
        } else {
            for (int idx = tid; idx < 30 * 128; idx += NTHR) { const int i = idx >> 7, c = idx & 127; u32x4 v;
                if (sample) v = pack8f(a.in[2] + ((size_t)(b * 30 + i)) * DM + c * 8); else v = (u32x4){0u, 0u, 0u, 0u};
                *(LAS u32x4*)(lds + i * 2048 + c * 16) = v; }
        }
#pragma unroll
        for (int it = 0; it < 8; ++it) *(LAS u32x4*)(lds + (30 + it * 4 + prow) * 2048 + pc * 16) = nw[it];
    }
    __syncthreads();
#pragma unroll 1
    for (int j = 0; j < ntiles; ++j) {
        const int rb = (32 * j) & 63; const int tokbase = tokbase0 + 32 * j; const bool more = j + 1 < ntiles;
        if (more) { const bf16_t* np = U + (size_t)(tokbase + 32 + prow) * DM + pc * 8;
#pragma unroll
            for (int it = 0; it < 8; ++it) nw[it] = *(const u32x4*)(np + (size_t)it * 4 * DM); }
        f32x2 acc[32];
#pragma unroll
        for (int t = 0; t < 32; ++t) acc[t] = cb;
        conv_row<0>(acc, wk, lds, rb, tid);
        __syncthreads();
        if (more) {
#pragma unroll
            for (int it = 0; it < 8; ++it) *(LAS u32x4*)(lds + ((rb + 62 + it * 4 + prow) & 63) * 2048 + pc * 16) = nw[it]; }
        float vals[64];
#pragma unroll
        for (int t = 0; t < 32; ++t) { vals[t] = acc[t].x + acc[t].y; vals[32 + t] = acc[t].x * acc[t].x + acc[t].y * acc[t].y; }
#define BFLY(off) { const bool up = (lane & (off)) != 0; _Pragma("unroll") for (int jj = 0; jj < (off); ++jj) { const float send = up ? vals[jj] : vals[jj + (off)]; const float keep = up ? vals[jj + (off)] : vals[jj]; vals[jj] = keep + __shfl_xor(send, (off)); } }
        BFLY(32) BFLY(16) BFLY(8) BFLY(4) BFLY(2) BFLY(1)
#undef BFLY
        LAS float* red = (LAS float*)(lds + CONV_RED_OFF); LAS f32x2* stat = (LAS f32x2*)(lds + CONV_STAT_OFF);
        red[w * 64 + lane] = vals[0];
        asm volatile("" ::: "memory");
        unsigned zq[32];
#pragma unroll
        for (int t = 0; t < 32; ++t) zq[t] = *(const unsigned*)(ZS + (size_t)(tokbase + t) * DM + 2 * tid);
        __syncthreads();
        if (tid < 32) { float s1 = 0.f, s2 = 0.f;
#pragma unroll
            for (int ww = 0; ww < 8; ++ww) { s1 += red[ww * 64 + tid]; s2 += red[ww * 64 + 32 + tid]; }
            const float mean = s1 * (1.f / DM); const float var = fmaxf(s2 * (1.f / DM) - mean * mean, 0.f);
            stat[tid] = (f32x2){mean, 1.0f / sqrtf(var + 1e-5f)}; }
        __syncthreads();
#pragma unroll
        for (int t = 0; t < 32; ++t) { const f32x2 st = stat[t]; const unsigned zv = zq[t];
            const float y0 = (acc[t].x - st.x) * st.y * lg.x + lb.x, y1 = (acc[t].y - st.x) * st.y * lg.y + lb.y;
            *(unsigned*)(A2 + (size_t)(tokbase + t) * 1536 + 2 * tid) = pk2(siluf_(y0) * bflo(zv), siluf_(y1) * bfhi(zv)); }
    }
    __syncthreads();
}

#define XB_TMO      128
#define XB_XCNT(j)  (256  + 64 * (j))
#define XB_XSUB(j)  (1280 + 64 * (j))
#define XB_XGEN(j)  (2304 + 64 * (j))
#define XB_TOP      3328
#define XB_TOPGEN   3392
#define XCD_BAR_WORDS 3456
#define XB_SPIN_CAP (1u << 18)

__device__ __forceinline__ unsigned xb_ld(unsigned* p)              { return __hip_atomic_load(p, __ATOMIC_RELAXED, __HIP_MEMORY_SCOPE_AGENT); }
__device__ __forceinline__ unsigned xb_add(unsigned* p, unsigned v) { return __hip_atomic_fetch_add(p, v, __ATOMIC_RELAXED, __HIP_MEMORY_SCOPE_AGENT); }
__device__ __forceinline__ unsigned xb_xcc_id() { return (unsigned)__builtin_amdgcn_s_getreg((3 << 11) | 20) & 0xFu; }
#define XB_SPIN(cond, bar) do { unsigned _sp = 0; while (cond) { __builtin_amdgcn_s_sleep(1); \
    if ((++_sp & 255u) == 0u) { if (xb_ld(&(bar)[XB_TMO])) break; if (_sp > XB_SPIN_CAP) { atomicAdd(&(bar)[XB_TMO], 1u); break; } } } } while (0)

struct XcdBarrier {
    unsigned* bar; unsigned x;
    volatile LAS unsigned* st;
};

__device__ __forceinline__ XcdBarrier xcd_barrier_post(unsigned* bar, volatile LAS unsigned* st) {
    XcdBarrier b; b.bar = bar; b.x = xb_xcc_id(); b.st = st;
    if (threadIdx.x == 0) (void)xb_add(&bar[XB_XCNT(b.x)], 1u);
    return b;
}
__device__ __forceinline__ void xcd_barrier_complete(unsigned* bar, unsigned x, unsigned& nloc, unsigned& nx) {
    const unsigned G = gridDim.x * gridDim.y * gridDim.z;
    unsigned sum, cnt, mine, sp = 0u;
    for (;;) {
        sum = 0u; cnt = 0u; mine = 0u;
#pragma unroll
        for (unsigned j = 0; j < 16; ++j) { const unsigned c = xb_ld(&bar[XB_XCNT(j)]); sum += c; cnt += (c > 0u) ? 1u : 0u; mine = (j == x) ? c : mine; }
        if (sum == G) break;
        __builtin_amdgcn_s_sleep(1);
        if ((++sp & 255u) == 0u) { if (xb_ld(&bar[XB_TMO])) break; if (sp > XB_SPIN_CAP) { atomicAdd(&bar[XB_TMO], 1u); break; } }
    }
    nloc = mine > 0u ? mine : 1u; nx = cnt > 0u ? cnt : 1u;
}

__device__ __forceinline__ void xcd_barrier(const XcdBarrier& b) {
    asm volatile("s_waitcnt vmcnt(0)" ::: "memory");
    __syncthreads();
    if (threadIdx.x == 0) {
        unsigned* bar = b.bar;
        __builtin_amdgcn_s_waitcnt(0);
        unsigned nloc = b.st[0], nx = b.st[1];
        if (nloc == 0u) { xcd_barrier_complete(bar, b.x, nloc, nx); b.st[0] = nloc; b.st[1] = nx; }
        const unsigned old = xb_add(&bar[XB_XSUB(b.x)], 1u);
        const unsigned gen = old / nloc;
        if (old + 1u == (gen + 1u) * nloc) {
            __builtin_amdgcn_fence(__ATOMIC_RELEASE, "agent");
            asm volatile("s_waitcnt vmcnt(0)" ::: "memory");
            const unsigned og = xb_add(&bar[XB_TOP], 1u);
            const unsigned tg = og / nx;
            if (og + 1u == (tg + 1u) * nx) xb_add(&bar[XB_TOPGEN], 1u);
            else XB_SPIN(xb_ld(&bar[XB_TOPGEN]) == tg, bar);
            __builtin_amdgcn_fence(__ATOMIC_ACQUIRE, "agent");
            xb_add(&bar[XB_XGEN(b.x)], 1u);
            asm volatile("s_waitcnt vmcnt(0)" ::: "memory");
        } else {
            XB_SPIN(xb_ld(&bar[XB_XGEN(b.x)]) == gen, bar);
            __builtin_amdgcn_fence(__ATOMIC_ACQUIRE, "agent");
            asm volatile("s_waitcnt vmcnt(0)" ::: "memory");
        }
    }
    __syncthreads();
}

__global__ void __launch_bounds__(NTHR, 2) mega_fwd(Args a) {
    extern __shared__ __attribute__((aligned(16))) unsigned char lds_raw[];
    LAS unsigned char* lds = (LAS unsigned char*)lds_raw;
    cg::grid_group grid = cg::this_grid();
    const int G = gridDim.x, lo = a.ph_lo, hi = a.ph_hi;
    unsigned char* ws = a.ws;
#ifndef PH_DISABLE
#define PH_DISABLE 0
#endif
#define IN(k) (lo <= (k) && (k) < hi && !((PH_DISABLE >> (k)) & 1))
#define SEAM(k) do { if (IN(k) && IN((k) + 1)) xcd_barrier(bar); } while (0)
    { volatile LAS unsigned* st = (volatile LAS unsigned*)(lds + LDS_BYTES - 64);
      if (threadIdx.x < 2) st[threadIdx.x] = 0u;
      __syncthreads(); }
    XcdBarrier bar = xcd_barrier_post((unsigned*)(ws + WS_CTL) + (lo == 0 ? 0 : XCD_BAR_WORDS), (volatile LAS unsigned*)(lds + LDS_BYTES - 64));
    if (hi > 1000) grid.sync();
    if (IN(0)) { prologue(a, lds, G); }
    SEAM(0);
    if (IN(1)) {
        pg8::Gemm g{(const bf16_t*)(ws + WS_H), (const bf16_t*)(ws + WS_WC), TP, 4096, 1024, 1024}; pg8::StaticOrder S; S.init(TP, 4096, G, (int)blockIdx.x);
        Epi1 E{(bf16_t*)(ws + WS_U), (bf16_t*)(ws + WS_Z), (bf16_t*)(ws + WS_XQ), (bf16_t*)(ws + WS_XZ), a.out, (const LAS float*)(lds + 131072)};
        {
            LAS float* rt = (LAS float*)(lds + 131072); const float* P0g = (const float*)(ws + WS_PS0);
            for (int i = (int)(threadIdx.x >> 8); i < 14; i += 2) { pg8::Unit uu; if (!S.next(i, uu)) break;
                rt[i * 256 + (threadIdx.x & 255)] = 1.0f / sqrtf(P0g[(size_t)uu.pm * 256 + (threadIdx.x & 255)] * (1.f / DM) + 1e-6f); }
            __syncthreads(); }
        pg8::gemm_phase<Epi1, pg8::StaticOrder, true, true>(lds, g, S, E);
    }
    SEAM(1);
    if (IN(2)) {
        unsigned* flag = (unsigned*)(ws + WS_CTL) + 7168;
        for (int e = blockIdx.x; e < 80; e += G) {
            if (e < 64) { pg8::Gemm g{(const bf16_t*)(ws + WS_H), (const bf16_t*)(ws + WS_WC), TT, 4096, 1024, 1024}; OneTile S{128 + (e >> 4), e & 15};
                Epi1 E{(bf16_t*)(ws + WS_U), (bf16_t*)(ws + WS_Z), (bf16_t*)(ws + WS_XQ), (bf16_t*)(ws + WS_XZ), a.out, (const LAS float*)(lds + 131072)};
                { LAS float* rt = (LAS float*)(lds + 131072); const float* P0g = (const float*)(ws + WS_PS0);
                  if (threadIdx.x < 256) rt[threadIdx.x] = 1.0f / sqrtf(P0g[(size_t)S.pm * 256 + threadIdx.x] * (1.f / DM) + 1e-6f);
                  __syncthreads(); }
                pg8::gemm_phase<Epi1, OneTile, true, true>(lds, g, S, E); }
            else { pg8::Gemm g{(const bf16_t*)(ws + WS_MP), (const bf16_t*)(ws + WS_WM), 512, 2048, 1024, 1024}; OneTile S{(e - 64) >> 3, (e - 64) & 7};
                EpiM E{(bf16_t*)(ws + WS_MK), (bf16_t*)(ws + WS_MV), a.out};
                pg8::gemm_phase<EpiM, OneTile, true, true>(lds, g, S, E); }
            asm volatile("s_waitcnt vmcnt(0)" ::: "memory"); __syncthreads();
            if (threadIdx.x == 0) { __builtin_amdgcn_fence(__ATOMIC_RELEASE, "agent"); asm volatile("s_waitcnt vmcnt(0)" ::: "memory"); (void)xb_add(flag, 1u); }
        }
        { const int tid = threadIdx.x; f32x2 wk[31];
#pragma unroll
          for (int k = 0; k < 31; ++k) wk[k] = *(const f32x2*)(a.in[10] + k * DM + 2 * tid);
          const f32x2 cb = *(const f32x2*)(a.in[11] + 2 * tid), lg = *(const f32x2*)(a.in[12] + 2 * tid), lb = *(const f32x2*)(a.in[13] + 2 * tid);
          const int sfirst = G >= 96 ? G - 16 : 0;
#pragma unroll 1
          for (int pass = 0; pass < 2; ++pass) {
              if (pass == 1) {
                  if (threadIdx.x == 0) { unsigned sp = 0; while (xb_ld(flag) < 80u) { __builtin_amdgcn_s_sleep(2); if (++sp > (1u << 22)) break; }
                      __builtin_amdgcn_fence(__ATOMIC_ACQUIRE, "agent"); asm volatile("s_waitcnt vmcnt(0)" ::: "memory"); }
                  __syncthreads(); }
              const int lim = pass ? 16 : 256;
#pragma unroll 1
              for (int idx = (int)blockIdx.x - (pass ? sfirst : 0); idx >= 0 && idx < lim; idx += G)
                  conv_run(a, lds, pass != 0, pass ? idx : idx >> 7, pass ? 0 : (idx & 127) * 4, pass ? 2 : 4, wk, cb, lg, lb);
          }
        }
    }
    if (IN(3)) {
        if (G >= 96) { const int c = blockIdx.x;
            if (c < 80) memattn_unit(a, lds, 0, c);
            else for (int u = c; u < 576; u += G - 80) memattn_unit(a, lds, 0, u);
        } else for (int u = blockIdx.x; u < 576; u += G) memattn_unit(a, lds, 0, u);
    }
    SEAM(3);
    if (IN(4)) {
        { pg8::Gemm g{(const bf16_t*)(ws + WS_A2), (const bf16_t*)(ws + WS_WO), TP, 1024, 1536, 1536}; pg8::StaticOrder S; S.init(TP, 1024, G, (int)blockIdx.x);
          Epi2a E{(bf16_t*)(ws + WS_H), (float*)(ws + WS_PS)};
#ifndef NO_MAIN
          pg8::gemm_phase<Epi2a, pg8::StaticOrder, true, true>(lds, g, S, E);
#endif
        }
        { pg8::Gemm g{(const bf16_t*)(ws + WS_A2), (const bf16_t*)(ws + WS_WO), TT, 1024, 384, 1536}; SplitOrder S{(int)blockIdx.x};
          EpiPart E{(float*)(ws + WS_PART)};
#ifndef NO_TAIL
          pg8::gemm_phase<EpiPart, SplitOrder, true, true>(lds, g, S, E);
#endif
        }
    }
    do { if (IN(4) && IN(6)) xcd_barrier(bar); } while (0);
    if (IN(6)) {
        pg8::Gemm g{(const bf16_t*)(ws + WS_H), (const bf16_t*)(ws + WS_WA), TT, 3328, 1024, 1024}; Order3 S{G, (int)blockIdx.x};
        Epi3 E{(bf16_t*)(ws + WS_U), (bf16_t*)(ws + WS_K), (bf16_t*)(ws + WS_V), (bf16_t*)(ws + WS_Z), (bf16_t*)(ws + WS_XQ), (bf16_t*)(ws + WS_XZ), a.out, (const float*)(ws + WS_PS), G >= 192 ? (const LAS float*)(lds + 131072) : (const LAS float*)nullptr};
        {
            LAS float* rt = (LAS float*)(lds + 131072); const float* PSg = (const float*)(ws + WS_PS);
            for (int i = (int)(threadIdx.x >> 8); i < 8; i += 2) { pg8::Unit uu; if (!S.next(i, uu)) break;
                const f32x4* pp = (const f32x4*)(PSg + ((size_t)uu.pm * 256 + (threadIdx.x & 255)) * 16); const f32x4 p0 = pp[0], p1 = pp[1], p2 = pp[2], p3 = pp[3];
                const float ssum = ((p0[0] + p0[1]) + (p0[2] + p0[3])) + ((p1[0] + p1[1]) + (p1[2] + p1[3])) + ((p2[0] + p2[1]) + (p2[2] + p2[3])) + ((p3[0] + p3[1]) + (p3[2] + p3[3]));
                rt[i * 256 + (threadIdx.x & 255)] = 1.0f / sqrtf(ssum * (1.f / DM) + 1e-6f); }
            __syncthreads(); }
        pg8::gemm_phase<Epi3, Order3, true, true>(lds, g, S, E);
        {
        const int tid = threadIdx.x, lane = tid & 63, wave = __builtin_amdgcn_readfirstlane(tid >> 6);
        const int gw = blockIdx.x * 8 + wave, NGW = G * 8; bf16_t* XB = (bf16_t*)(ws + WS_H); float* PS = (float*)(ws + WS_PS);
        const float* PART = (const float*)(ws + WS_PART);
        for (int mm = TP + gw; mm < TT; mm += NGW) {
            const size_t ro = (size_t)(mm - TP) * DM;
            const f32x4* xr = (const f32x4*)(a.in[1] + ro) + lane; u32x2* o8 = (u32x2*)(XB + (size_t)mm * DM) + lane; float s = 0.f;
#pragma unroll
            for (int j = 0; j < 4; ++j) { f32x4 v = xr[64 * j];
#pragma unroll
                for (int ks = 0; ks < 4; ++ks) v += ((const f32x4*)(PART + (size_t)ks * TSMP * DM + ro) + lane)[64 * j];
                s += (v.x * v.x + v.y * v.y) + (v.z * v.z + v.w * v.w); u32x2 w; w.x = pk2(v.x, v.y); w.y = pk2(v.z, v.w); o8[64 * j] = w; }
            s = wave_sum(s);
            if (lane < 16) PS[(size_t)mm * 16 + lane] = lane == 0 ? s : 0.f;
        }
            }
    }
    SEAM(6);
    if (IN(7)) {
        unsigned* flag = (unsigned*)(ws + WS_CTL) + 7232;
        for (int e = blockIdx.x; e < 180; e += G) {
            pg8::Gemm g{(const bf16_t*)(ws + WS_H), (const bf16_t*)(ws + WS_WA), TT, 3328, 1024, 1024};
            OneTile S{e < 52 ? 128 + e / 13 : 96 + ((e - 52) >> 2), e < 52 ? e % 13 : 9 + ((e - 52) & 3)};
            Epi3 E{(bf16_t*)(ws + WS_U), (bf16_t*)(ws + WS_K), (bf16_t*)(ws + WS_V), (bf16_t*)(ws + WS_Z), (bf16_t*)(ws + WS_XQ), (bf16_t*)(ws + WS_XZ), a.out, (const float*)(ws + WS_PS), (const LAS float*)(lds + 131072)};
            { LAS float* rt = (LAS float*)(lds + 131072); const float* PSg = (const float*)(ws + WS_PS);
              if (threadIdx.x < 256) { const f32x4* pp = (const f32x4*)(PSg + ((size_t)S.pm * 256 + threadIdx.x) * 16); const f32x4 p0 = pp[0], p1 = pp[1], p2 = pp[2], p3 = pp[3];
                  const float ssum = ((p0[0] + p0[1]) + (p0[2] + p0[3])) + ((p1[0] + p1[1]) + (p1[2] + p1[3])) + ((p2[0] + p2[1]) + (p2[2] + p2[3])) + ((p3[0] + p3[1]) + (p3[2] + p3[3]));
                  rt[threadIdx.x] = 1.0f / sqrtf(ssum * (1.f / DM) + 1e-6f); }
              __syncthreads(); }
            pg8::gemm_phase<Epi3, OneTile, true, true>(lds, g, S, E);
            asm volatile("s_waitcnt vmcnt(0)" ::: "memory"); __syncthreads();
            if (threadIdx.x == 0) { __builtin_amdgcn_fence(__ATOMIC_RELEASE, "agent"); asm volatile("s_waitcnt vmcnt(0)" ::: "memory"); (void)xb_add(flag, 1u); }
        }
        const int sfirst = G >= 64 ? G - 32 : 0;
#pragma unroll 1
        for (int pass = 0; pass < 2; ++pass) {
            if (pass == 1) {
                if (threadIdx.x == 0) { unsigned sp = 0; while (xb_ld(flag) < 180u) { __builtin_amdgcn_s_sleep(2); if (++sp > (1u << 22)) break; }
                    __builtin_amdgcn_fence(__ATOMIC_ACQUIRE, "agent"); asm volatile("s_waitcnt vmcnt(0)" ::: "memory"); }
                __syncthreads(); }
            const int first = pass ? ((int)blockIdx.x >= sfirst ? 1024 + (int)blockIdx.x - sfirst : 1056) : (int)blockIdx.x;
            swa_phase(a, lds, first, G, pass ? 1056 : 1024);
        }
    }
    if (IN(8)) {
        const int c = blockIdx.x; const bool bal = G >= 224;
#pragma unroll 1
        for (int k = 0; ; ++k) { int u;
            if (!bal) u = c + k * G; else if (c < 180) u = k < 2 ? c + 180 * k : 576; else u = 360 + (c - 180) + k * (G - 180);
            if (u >= 576) break;
            memattn_unit(a, lds, 1, u); }
    }
    SEAM(8);
    if (IN(9)) {
        { pg8::Gemm g{(const bf16_t*)(ws + WS_A2), (const bf16_t*)(ws + WS_WO) + (size_t)1024 * 1536, TP, 1024, 1536, 1536}; pg8::StaticOrder S; S.init(TP, 1024, G, (int)blockIdx.x);
          Epi2 E{(const bf16_t*)(ws + WS_H), (bf16_t*)(ws + WS_U)};
          pg8::gemm_phase<Epi2, pg8::StaticOrder, true, true>(lds, g, S, E); }
        { pg8::Gemm g{(const bf16_t*)(ws + WS_A2), (const bf16_t*)(ws + WS_WO) + (size_t)1024 * 1536, TT, 1024, 384, 1536}; SplitOrder S{(int)blockIdx.x};
          EpiPart E{(float*)(ws + WS_PART)};
#ifndef NO_TAIL
          pg8::gemm_phase<EpiPart, SplitOrder, true, true>(lds, g, S, E);
#endif
        }
    }
    SEAM(9);
    if (IN(10)) {
        const int tid = threadIdx.x, lane = tid & 63, wave = __builtin_amdgcn_readfirstlane(tid >> 6);
        const int gw = blockIdx.x * 8 + wave, NGW = G * 8;
        { int m = gw;
          for (; m + 3 * NGW < TP; m += 4 * NGW) rms_rows_final<4>((const bf16_t*)(ws + WS_U), a.out, m, NGW, a.in[18], lane);
          for (; m < TP; m += NGW) rms_rows_final<1>((const bf16_t*)(ws + WS_U), a.out, m, NGW, a.in[18], lane);
          for (m = TP + gw; m < TT; m += NGW) rms_row_final((const bf16_t*)(ws + WS_H) + (size_t)m * DM, a.out + (size_t)m * DM, a.in[18], lane, (const float*)(ws + WS_PART) + (size_t)(m - TP) * DM); }
    }
#undef IN
#undef SEAM
}

#ifndef MK_ONE_LAUNCH
#define MK_ONE_LAUNCH 1
#endif
extern "C" void kernel_launch(void* const* d_in, const int* in_sizes, int n_in, void* d_out, int out_size, void* d_ws, size_t ws_size, hipStream_t stream) {
    static int grid = 0;
    if (grid == 0) {
        if (n_in != 19 || (size_t)out_size != O_TOTAL || ws_size < WS_END) { fprintf(stderr, "kernel_launch: unexpected shapes (n_in %d out %d ws %zu)\n", n_in, out_size, ws_size); grid = -1; return; }
        int dev = 0, cus = 0, per_cu = 0;
        (void)hipGetDevice(&dev); (void)hipDeviceGetAttribute(&cus, hipDeviceAttributeMultiprocessorCount, dev);
        if (hipFuncSetAttribute((const void*)mega_fwd, hipFuncAttributeMaxDynamicSharedMemorySize, LDS_BYTES) != hipSuccess) { fprintf(stderr, "kernel_launch: hipFuncSetAttribute failed\n"); grid = -1; return; }
        if (hipOccupancyMaxActiveBlocksPerMultiprocessor(&per_cu, (const void*)mega_fwd, NTHR, LDS_BYTES) != hipSuccess || per_cu < 1) { fprintf(stderr, "kernel_launch: occupancy query says %d\n", per_cu); per_cu = 1; }
        (void)hipGetLastError();
        grid = cus;
    }
    if (grid < 0) return;
    if (hipMemsetAsync((char*)d_ws + WS_CTL, 0, CTL_BYTES, stream) != hipSuccess) { fprintf(stderr, "kernel_launch: memset failed\n"); return; }
    Args a{};
    for (int i = 0; i < 19; ++i) a.in[i] = (const float*)d_in[i];
    a.out = (float*)d_out; a.ws = (unsigned char*)d_ws;
#if MK_ONE_LAUNCH
#ifdef PROBE_SPLIT
    { a.ph_lo = 0; a.ph_hi = PROBE_SPLIT + 1; void* args0[] = {&a};
      (void)hipLaunchCooperativeKernel((const void*)mega_fwd, dim3(grid), dim3(NTHR), args0, LDS_BYTES, stream);
      a.ph_lo = PROBE_SPLIT; }
#else
    a.ph_lo = 0;
#endif
    a.ph_hi = 11;
    void* args[] = {&a};
    hipError_t e = hipLaunchCooperativeKernel((const void*)mega_fwd, dim3(grid), dim3(NTHR), args, LDS_BYTES, stream);
    if (e != hipSuccess) fprintf(stderr, "kernel_launch: cooperative launch failed: %s (grid %d)\n", hipGetErrorString(e), grid);
#else
    for (int p = 0; p < 11; ++p) { a.ph_lo = p; a.ph_hi = p + 1; hipLaunchKernelGGL(mega_fwd, dim3(grid), dim3(NTHR), LDS_BYTES, stream, a); }
#endif
}
```

```cpp
#include <hip/hip_runtime.h>
#include <hip/hip_cooperative_groups.h>
#include <cstdio>
#include <cstdint>
namespace cg = cooperative_groups;
namespace pg8 {
#define PG8_LAS __attribute__((address_space(3)))
typedef unsigned short bf16_t;
typedef short bf16x8 __attribute__((ext_vector_type(8)));
typedef float f32x4 __attribute__((ext_vector_type(4)));
typedef unsigned u32x4 __attribute__((ext_vector_type(4)));
constexpr int BM = 256, BK = 64, HALF = 128, HTB = HALF * BK * 2  , STAGE_BYTES = 8 * HTB, NXCD = 8, WGM = 8;

__host__ __device__ __forceinline__ int lds_byte(int r, int c) { const int st = (r >> 4) * 2 + (c >> 5), rr = r & 15, cc = c & 31, ob = rr * 64 + cc * 2; return st * 1024 + (ob ^ (((ob >> 9) & 1) << 5)); }
__host__ __device__ __forceinline__ void stage_rc(int b, int& R, int& C) { const int st = b / 1024, sb = b % 1024, swz = sb ^ (((sb >> 9) & 1) << 5); R = (st >> 1) * 16 + swz / 64; C = (st & 1) * 32 + (swz % 64) / 2; }
__host__ __device__ __forceinline__ int perm32(int rho) { const int n = rho >> 4, i = rho & 15; return 8 * (i >> 2) + 4 * n + (i & 3); }

struct Unit { int pm, pn, ko, ix; };
struct Gemm { const bf16_t* A; const bf16_t* Bt; int M, N, K, ld; };

struct StaticOrder {
    int nM, nN, nwg, G, c;
    __host__ __device__ void init(int M, int N, int G_, int c_) { nM = M / BM; nN = N / BM; nwg = nM * nN; G = G_; c = c_; }
    __host__ __device__ bool next(int i, Unit& u) const {
        const long L = (long)i * G + c; if (L >= nwg) return false;
        int wgid = (int)L; { const int q = nwg / NXCD, r = nwg % NXCD, xcd = wgid % NXCD, off = wgid / NXCD; wgid = (xcd < r ? xcd * (q + 1) : r * (q + 1) + (xcd - r) * q) + off; }
        const int nig = WGM * nN, gid = wgid / nig, fm = gid * WGM, gsz = (nM - fm) < WGM ? (nM - fm) : WGM;
        u.pm = fm + ((wgid % nig) % gsz); u.pn = (wgid % nig) / gsz; u.ko = 0; u.ix = i; return true;
    }
    __device__ __forceinline__ void a_ready(const Unit&) const {}
    __device__ __forceinline__ void done(const Unit&) const {}
};

__device__ __forceinline__ unsigned cvt_pk_bf16(float lo, float hi) { unsigned r; asm volatile("v_cvt_pk_bf16_f32 %0, %1, %2" : "=v"(r) : "v"(lo), "v"(hi)); return r; }
typedef float f32x2 __attribute__((ext_vector_type(2)));
template <class Epi, class Sched, bool ALIGN_EPI = false, bool SP2 = false>
__device__ __forceinline__ void gemm_phase(PG8_LAS unsigned char* lds, const Gemm g, const Sched& S, const Epi& E) {
    const int tid = threadIdx.x, wid = __builtin_amdgcn_readfirstlane(tid >> 6), lane = tid & 63, wr = wid >> 2, wc = wid & 3, fr = lane & 15, fq = lane >> 4;
    const int K = g.ld, nt = g.K / BK;
    unsigned voffA[2], voffB[2];
#pragma unroll
    for (int i = 0; i < 2; ++i) { int R, C; stage_rc(tid * 16 + i * 8192, R, C); const int Rb = Epi::PERM ? ((R & ~31) + perm32(R & 31)) : R;
        voffA[i] = (unsigned)(R * K + C) * 2u; voffB[i] = (unsigned)(Rb * K + C) * 2u; }
    const size_t kstep = (size_t)(BK * 2);
    const size_t hstep = (size_t)HALF * K * 2;
    const size_t tstep = 2 * hstep;
    const unsigned ldsw = (unsigned)wid * 1024u;
    const int aoff = lds_byte(wr * 64 + fr, fq * 8), boff = lds_byte(wc * 32 + fr, fq * 8);
#define PG8_SA(b, h) (((b) * 2 + (h)) * HTB)
#define PG8_SB(b, h) ((4 + (b) * 2 + (h)) * HTB)
#define PG8_STAGE(bufoff, gbase, voff) do { _Pragma("unroll") for (int _i = 0; _i < 2; ++_i) \
        __builtin_amdgcn_global_load_lds((const unsigned*)((const char*)(gbase) + (voff)[_i]), (PG8_LAS unsigned*)(lds + (bufoff) + ldsw + _i * 8192), 16, 0, 0); } while (0)
#define PG8_LDA(dst, b, h) do { _Pragma("unroll") for (int m = 0; m < 4; ++m) _Pragma("unroll") for (int k = 0; k < 2; ++k) dst[m][k] = *(const PG8_LAS bf16x8*)(lds + PG8_SA(b, h) + aoff + m * 2048 + k * 1024); } while (0)
#define PG8_LDB(dst, b, h) do { _Pragma("unroll") for (int n = 0; n < 2; ++n) _Pragma("unroll") for (int k = 0; k < 2; ++k) dst[n][k] = *(const PG8_LAS bf16x8*)(lds + PG8_SB(b, h) + boff + n * 2048 + k * 1024); } while (0)
#define PG8_MMA(ai, bj, At, Bt) do { __builtin_amdgcn_s_setprio(1); _Pragma("unroll") for (int m = 0; m < 4; ++m) _Pragma("unroll") for (int n = 0; n < 2; ++n) _Pragma("unroll") for (int k = 0; k < 2; ++k) \
        acc[ai][bj][m][n] = __builtin_amdgcn_mfma_f32_16x16x32_bf16(Bt[n][k], At[m][k], acc[ai][bj][m][n], 0, 0, 0); __builtin_amdgcn_s_setprio(0); } while (0)
#define PG8_WAIT_V(n) asm volatile("s_waitcnt vmcnt(" #n ")" ::: "memory")
#define PG8_WAIT_L(n) asm volatile("s_waitcnt lgkmcnt(" #n ")" ::: "memory")
#define PG8_BAR __builtin_amdgcn_s_barrier()
#define PG8_SCHED __builtin_amdgcn_sched_barrier(0)
    Unit cur, nxt; int ui = 0;
    if (!S.next(0, cur)) return;
    f32x4 acc[2][2][4][2];
#pragma unroll
    for (int a = 0; a < 2; ++a)
#pragma unroll
        for (int b = 0; b < 2; ++b)
#pragma unroll
            for (int m = 0; m < 4; ++m)
#pragma unroll
                for (int n = 0; n < 2; ++n) acc[a][b][m][n] = (f32x4){0.f, 0.f, 0.f, 0.f};
    bf16x8 At[4][2], B0[2][2], B1[2][2];
    const char* cA = (const char*)g.A + (size_t)cur.pm * tstep + (size_t)cur.ko * 2; const char* cB = (const char*)g.Bt + (size_t)cur.pn * tstep + (size_t)cur.ko * 2;
    S.a_ready(cur);
    if constexpr (SP2) {
        PG8_STAGE(PG8_SB(0, 0), cB, voffB); PG8_STAGE(PG8_SB(0, 1), cB + hstep, voffB); PG8_STAGE(PG8_SA(0, 0), cA, voffA); PG8_STAGE(PG8_SA(0, 1), cA + hstep, voffA);
        if (wr == 1) PG8_BAR;
        PG8_WAIT_V(2); PG8_BAR;
        PG8_STAGE(PG8_SB(1, 0), cB + kstep, voffB); PG8_STAGE(PG8_SA(1, 0), cA + kstep, voffA); PG8_STAGE(PG8_SB(1, 1), cB + hstep + kstep, voffB);
        PG8_WAIT_V(6); PG8_BAR;
    } else {
        PG8_STAGE(PG8_SB(0, 0), cB, voffB); PG8_STAGE(PG8_SA(0, 0), cA, voffA); PG8_STAGE(PG8_SB(0, 1), cB + hstep, voffB); PG8_STAGE(PG8_SA(0, 1), cA + hstep, voffA);
        if (wr == 1) PG8_BAR;
        PG8_WAIT_V(4); PG8_BAR;
        PG8_STAGE(PG8_SB(1, 0), cB + kstep, voffB); PG8_STAGE(PG8_SA(1, 0), cA + kstep, voffA); PG8_STAGE(PG8_SB(1, 1), cB + hstep + kstep, voffB);
        PG8_WAIT_V(6); PG8_BAR;
    }
    for (;;) {
        const bool has_next = S.next(ui + 1, nxt);
        const char* nA = has_next ? (const char*)g.A + (size_t)nxt.pm * tstep + (size_t)nxt.ko * 2 : cA; const char* nB = has_next ? (const char*)g.Bt + (size_t)nxt.pn * tstep + (size_t)nxt.ko * 2 : cB;
#pragma unroll 1
        for (int t = 0; t < nt; t += 2) {
            const bool last = (t == nt - 2);
            const char* a1 = cA + (size_t)(t + 1) * kstep;
            const char* a2 = last ? nA : cA + (size_t)(t + 2) * kstep; const char* b2 = last ? nB : cB + (size_t)(t + 2) * kstep;
            const char* a3 = a2 + kstep; const char* b3 = b2 + kstep;
            if (last && has_next) S.a_ready(nxt);
            if constexpr (SP2) {
            PG8_LDB(B0, 0, 0); PG8_LDB(B1, 0, 1); PG8_SCHED; PG8_LDA(At, 0, 0); PG8_STAGE(PG8_SA(1, 1), a1 + hstep, voffA);
            PG8_WAIT_V(8); PG8_WAIT_L(0); PG8_BAR; PG8_MMA(0, 0, At, B0); PG8_MMA(0, 1, At, B1); PG8_BAR; PG8_SCHED;
            PG8_LDA(At, 0, 1); PG8_STAGE(PG8_SB(0, 0), b2, voffB); PG8_STAGE(PG8_SB(0, 1), b2 + hstep, voffB); PG8_STAGE(PG8_SA(0, 0), a2, voffA);
            PG8_WAIT_V(8); PG8_WAIT_L(0); PG8_BAR; PG8_MMA(1, 0, At, B0); PG8_MMA(1, 1, At, B1); PG8_BAR; PG8_SCHED;
            PG8_LDB(B0, 1, 0); PG8_LDB(B1, 1, 1); PG8_SCHED; PG8_LDA(At, 1, 0); PG8_STAGE(PG8_SA(0, 1), a2 + hstep, voffA);
            PG8_WAIT_V(8); PG8_WAIT_L(0); PG8_BAR; PG8_MMA(0, 0, At, B0); PG8_MMA(0, 1, At, B1); PG8_BAR; PG8_SCHED;
            PG8_LDA(At, 1, 1); PG8_STAGE(PG8_SB(1, 0), b3, voffB); PG8_STAGE(PG8_SB(1, 1), b3 + hstep, voffB); PG8_STAGE(PG8_SA(1, 0), a3, voffA);
            PG8_WAIT_V(8); PG8_WAIT_L(0); PG8_BAR; PG8_MMA(1, 0, At, B0); PG8_MMA(1, 1, At, B1); PG8_BAR; PG8_SCHED;
            } else {
            PG8_LDB(B0, 0, 0); PG8_SCHED; PG8_LDA(At, 0, 0); PG8_STAGE(PG8_SA(1, 1), a1 + hstep, voffA);
            PG8_WAIT_L(8); PG8_BAR; PG8_WAIT_L(0); PG8_MMA(0, 0, At, B0); PG8_BAR; PG8_SCHED;
            PG8_LDB(B1, 0, 1); PG8_STAGE(PG8_SB(0, 0), b2, voffB);
            PG8_BAR; PG8_WAIT_L(0); PG8_MMA(0, 1, At, B1); PG8_BAR;
            PG8_LDA(At, 0, 1); PG8_STAGE(PG8_SA(0, 0), a2, voffA);
            PG8_BAR; PG8_WAIT_L(0); PG8_MMA(1, 0, At, B0); PG8_BAR; PG8_SCHED;
            PG8_STAGE(PG8_SB(0, 1), b2 + hstep, voffB);
            PG8_WAIT_V(6); PG8_BAR; PG8_MMA(1, 1, At, B1); PG8_BAR;
            PG8_LDB(B0, 1, 0); PG8_SCHED; PG8_LDA(At, 1, 0); PG8_STAGE(PG8_SA(0, 1), a2 + hstep, voffA);
            PG8_WAIT_L(8); PG8_BAR; PG8_WAIT_L(0); PG8_MMA(0, 0, At, B0); PG8_BAR; PG8_SCHED;
            PG8_LDB(B1, 1, 1); PG8_STAGE(PG8_SB(1, 0), b3, voffB);
            PG8_BAR; PG8_WAIT_L(0); PG8_MMA(0, 1, At, B1); PG8_BAR;
            PG8_LDA(At, 1, 1); PG8_STAGE(PG8_SA(1, 0), a3, voffA);
            PG8_BAR; PG8_WAIT_L(0); PG8_MMA(1, 0, At, B0); PG8_BAR; PG8_SCHED;
            PG8_STAGE(PG8_SB(1, 1), b3 + hstep, voffB);
            PG8_WAIT_V(6); PG8_BAR; PG8_MMA(1, 1, At, B1); PG8_BAR;
            }
        }
        if constexpr (ALIGN_EPI) { if (wr == 0) PG8_BAR; }
        if constexpr (!Epi::AFTER_DRAIN) { E(acc, cur, wr, wc, fr, fq); S.done(cur); }
        if (!has_next) break;
#pragma unroll
        for (int a = 0; a < 2; ++a)
#pragma unroll
            for (int b = 0; b < 2; ++b)
#pragma unroll
                for (int m = 0; m < 4; ++m)
#pragma unroll
                    for (int n = 0; n < 2; ++n) acc[a][b][m][n] = (f32x4){0.f, 0.f, 0.f, 0.f};
        cur = nxt; cA = nA; cB = nB; ++ui;
        if constexpr (ALIGN_EPI) { if (wr == 1) PG8_BAR; }
    }
    PG8_WAIT_V(0);
    if constexpr (!ALIGN_EPI) { if (wr == 0) PG8_BAR; }
    PG8_BAR;
    if constexpr (Epi::AFTER_DRAIN) { E.fused(acc, cur, wr, wc, fr, fq, lds, wid, lane); S.done(cur); }
#undef PG8_SA
#undef PG8_SB
#undef PG8_STAGE
#undef PG8_LDA
#undef PG8_LDB
#undef PG8_MMA
#undef PG8_WAIT_V
#undef PG8_WAIT_L
#undef PG8_BAR
#undef PG8_SCHED
}
}


#define LAS __attribute__((address_space(3)))
#define DI __device__ __forceinline__
using pg8::bf16_t; using pg8::bf16x8; using pg8::f32x4; using pg8::u32x4;
typedef short s16x4 __attribute__((ext_vector_type(4)));
typedef float f32x16 __attribute__((ext_vector_type(16)));
typedef float f32x2 __attribute__((ext_vector_type(2)));
typedef unsigned u32x2 __attribute__((ext_vector_type(2)));
typedef __bf16 bf16x2_t __attribute__((ext_vector_type(2)));

constexpr int TP = 32768, TSMP = 1024, TT = TP + TSMP;
constexpr int DM = 1024;
constexpr int NTHR = 512;
constexpr float LOG2E = 1.4426950408889634f;
constexpr float QSCALE = 0.125f * LOG2E;
constexpr float XSCALE = 0.08838834764831845f * LOG2E;
constexpr size_t MiB = 1u << 20;
constexpr size_t WS_PART = 416 * MiB;
constexpr size_t WS_CTL = 31 * MiB, CTL_BYTES = 65536;
constexpr size_t WS_PS = 28 * MiB;
constexpr size_t WS_WC = 0, WS_WA = 8 * MiB, WS_WO = 15 * MiB, WS_WM = 21 * MiB, WS_MP = 25 * MiB, WS_MK = 26 * MiB, WS_MV = 27 * MiB;
constexpr size_t WS_H = 32 * MiB, WS_U = 98 * MiB, WS_Z = 164 * MiB, WS_XQ = 230 * MiB, WS_XZ = 263 * MiB, WS_A2 = 296 * MiB, WS_K = 395 * MiB, WS_V = 404 * MiB, WS_END = 432 * MiB;
constexpr size_t O_Y = 0, O_CONVP = 34603008, O_CONVS = 34664448, O_KP = 35155968, O_VP = 35188736, O_KS = 35221504, O_VS = 35483648, O_MKP = 35745792, O_MVP = 36270080, O_TOTAL = 36794368;
constexpr int LDS_BYTES = 147456;

struct Args {
    const float* in[19]; float* out; unsigned char* ws; int ph_lo, ph_hi;
};

DI unsigned pk2(float lo, float hi) { f32x2 v = {lo, hi}; bf16x2_t b = __builtin_convertvector(v, bf16x2_t); return __builtin_bit_cast(unsigned, b); }
DI float bflo(unsigned u) { return __uint_as_float(u << 16); }
DI float bfhi(unsigned u) { return __uint_as_float(u & 0xffff0000u); }
DI float sigmoidf_(float x) { return __builtin_amdgcn_rcpf(1.0f + __expf(-x)); }
DI float siluf_(float x) { return x * sigmoidf_(x); }
DI u32x4 pack8(f32x4 a, f32x4 b) { u32x4 w; w.x = pk2(a[0], a[1]); w.y = pk2(a[2], a[3]); w.z = pk2(b[0], b[1]); w.w = pk2(b[2], b[3]); return w; }
DI u32x4 pack8f(const float* s) { f32x4 a = *(const f32x4*)s, b = *(const f32x4*)(s + 4); return pack8(a, b); }
DI float wave_sum(float v) {
#pragma unroll
    for (int o = 1; o < 64; o <<= 1) v += __shfl_xor(v, o);
    return v;
}

#define ROWLOOP _Pragma("unroll") for (int ai = 0; ai < 2; ++ai) _Pragma("unroll") for (int m = 0; m < 4; ++m)
#define ROWDEF const int row = row0 + ai * 128 + m * 16;
#define RSRDEF float rsr; if (rs_lds) rsr = rs_lds[u.ix * 256 + (row & 255)]; else { const f32x4* pp = (const f32x4*)(PS + (size_t)row * 16); const f32x4 p0 = pp[0], p1 = pp[1], p2 = pp[2], p3 = pp[3]; \
    const float ssum = ((p0[0] + p0[1]) + (p0[2] + p0[3])) + ((p1[0] + p1[1]) + (p1[2] + p1[3])) + ((p2[0] + p2[1]) + (p2[2] + p2[3])) + ((p3[0] + p3[1]) + (p3[2] + p3[3])); \
    rsr = 1.0f / sqrtf(ssum * (1.f / DM) + 1e-6f); }

struct Epi1 {
    static constexpr bool PERM = true, AFTER_DRAIN = false;
    bf16_t *U, *ZS, *XQ, *XZ; float* out;
    DI void operator()(const f32x4 (&acc)[2][2][4][2], const pg8::Unit& u, int wr, int wc, int fr, int fq) const {
        const int row0 = u.pm * 256 + wr * 64 + fr; const int pn = u.pn; const int cw = wc * 32 + 8 * fq;
        if (pn < 8) {
            const int ch0 = pn * 128 + cw;
            ROWLOOP { ROWDEF
                f32x4 u0, u1;
#pragma unroll
                for (int j = 0; j < 4; ++j) { u0[j] = acc[ai][0][m][0][j] * sigmoidf_(acc[ai][1][m][0][j]); u1[j] = acc[ai][0][m][1][j] * sigmoidf_(acc[ai][1][m][1][j]); }
                *(u32x4*)(U + (size_t)row * DM + ch0) = pack8(u0, u1);
                float* cp = nullptr;
                if (row < TP) { const int t = row & 16383; if (t >= 16354) cp = out + O_CONVP + ((size_t)((row >> 14) * 30 + (t - 16354))) * DM + ch0; }
                else { const int r2 = row - TP, t = r2 & 63; if (t >= 34) cp = out + O_CONVS + ((size_t)((r2 >> 6) * 30 + (t - 34))) * DM + ch0; }
                if (cp) { *(f32x4*)cp = u0; *(f32x4*)(cp + 4) = u1; }
             }
        } else if (pn < 12) {
#pragma unroll
            for (int bj = 0; bj < 2; ++bj) { const int col = (pn - 8) * 256 + bj * 128 + cw;
                ROWLOOP { ROWDEF  f32x4 a = acc[ai][bj][m][0], b = acc[ai][bj][m][1];
#pragma unroll
                    for (int j = 0; j < 4; ++j) { a[j] = siluf_(a[j]); b[j] = siluf_(b[j]); }
                    *(u32x4*)(ZS + (size_t)row * DM + col) = pack8(a, b);  } }
        } else if (pn < 14) {
#pragma unroll
            for (int bj = 0; bj < 2; ++bj) { const int col = (pn - 12) * 256 + bj * 128 + cw;
                ROWLOOP { ROWDEF  *(u32x4*)(XQ + (size_t)row * 512 + col) = pack8(acc[ai][bj][m][0] * XSCALE, acc[ai][bj][m][1] * XSCALE);  } }
        } else {
#pragma unroll
            for (int bj = 0; bj < 2; ++bj) { const int col = (pn - 14) * 256 + bj * 128 + cw;
                ROWLOOP { ROWDEF  f32x4 a = acc[ai][bj][m][0], b = acc[ai][bj][m][1];
#pragma unroll
                    for (int j = 0; j < 4; ++j) { a[j] = siluf_(a[j]); b[j] = siluf_(b[j]); }
                    *(u32x4*)(XZ + (size_t)row * 512 + col) = pack8(a, b);  } }
        }
    }
};

struct Epi3 {
    static constexpr bool PERM = true, AFTER_DRAIN = false;
    bf16_t *Q, *KB, *VB, *ZS, *XQ, *XZ; float* out; const float* PS; const LAS float* rs_lds;
    DI void operator()(const f32x4 (&acc)[2][2][4][2], const pg8::Unit& u, int wr, int wc, int fr, int fq) const {
        const int row0 = u.pm * 256 + wr * 64 + fr; const int pn = u.pn; const int cw = wc * 32 + 8 * fq;
        if (pn < 5) {
            const int d1 = 16 * (wc & 1) + 4 * fq;
            float invrev[4];
#pragma unroll
            for (int j = 0; j < 4; ++j) invrev[j] = __builtin_amdgcn_exp2f(-(float)(d1 + j) * 0.41524101186092033f) * 0.15915494309189535f;
            ROWLOOP { ROWDEF RSRDEF
                const int pos = row < TP ? (row & 16383) : 2048 + ((row - TP) & 63);
                float cs[4], sn[4];
#pragma unroll
                for (int j = 0; j < 4; ++j) { const float rr = __builtin_amdgcn_fractf((float)pos * invrev[j]); cs[j] = __builtin_amdgcn_cosf(rr); sn[j] = __builtin_amdgcn_sinf(rr); }
                if (pn < 4) {
#pragma unroll
                    for (int bj = 0; bj < 2; ++bj) { const int head = pn * 4 + bj * 2 + (wc >> 1);
                        f32x4 x1 = (acc[ai][bj][m][0] * rsr), x2 = (acc[ai][bj][m][1] * rsr), o1, o2;
#pragma unroll
                        for (int j = 0; j < 4; ++j) { o1[j] = (x1[j] * cs[j] - x2[j] * sn[j]) * QSCALE; o2[j] = (x2[j] * cs[j] + x1[j] * sn[j]) * QSCALE; }
                        bf16_t* qp = Q + (size_t)row * DM + head * 64 + d1;
                        u32x2 w1, w2; w1.x = pk2(o1[0], o1[1]); w1.y = pk2(o1[2], o1[3]); w2.x = pk2(o2[0], o2[1]); w2.y = pk2(o2[2], o2[3]);
                        *(u32x2*)qp = w1; *(u32x2*)(qp + 32) = w2; }
                } else {
                    float* kc = nullptr; float* vc = nullptr;
                    if (row < TP) { const int t = row & 16383; if (t >= 16256) { const size_t o = ((size_t)((row >> 14) * 128 + (t - 16256))) * 128; kc = out + O_KP + o; vc = out + O_VP + o; } }
                    else { const int r2 = row - TP; const size_t o = ((size_t)((r2 >> 6) * 128 + 64 + (r2 & 63))) * 128; kc = out + O_KS + o; vc = out + O_VS + o; }
                    { const int kvh = wc >> 1;
                        f32x4 x1 = (acc[ai][0][m][0] * rsr), x2 = (acc[ai][0][m][1] * rsr), o1, o2;
#pragma unroll
                        for (int j = 0; j < 4; ++j) { o1[j] = x1[j] * cs[j] - x2[j] * sn[j]; o2[j] = x2[j] * cs[j] + x1[j] * sn[j]; }
                        bf16_t* kp = KB + (size_t)row * 128 + kvh * 64 + d1;
                        u32x2 w1, w2; w1.x = pk2(o1[0], o1[1]); w1.y = pk2(o1[2], o1[3]); w2.x = pk2(o2[0], o2[1]); w2.y = pk2(o2[2], o2[3]);
                        *(u32x2*)kp = w1; *(u32x2*)(kp + 32) = w2;
                        if (kc) { *(f32x4*)(kc + kvh * 64 + d1) = o1; *(f32x4*)(kc + kvh * 64 + d1 + 32) = o2; } }
                    { f32x4 a = (acc[ai][1][m][0] * rsr), b = (acc[ai][1][m][1] * rsr);
                        *(u32x4*)(VB + (size_t)row * 128 + cw) = pack8(a, b);
                        if (vc) { *(f32x4*)(vc + cw) = a; *(f32x4*)(vc + cw + 4) = b; } }
                }
             }
        } else if (pn < 9) {
            ROWLOOP { ROWDEF RSRDEF
#pragma unroll
                for (int bj = 0; bj < 2; ++bj) { const int col = (pn - 5) * 256 + bj * 128 + cw;
                    f32x4 a = (acc[ai][bj][m][0] * rsr), b = (acc[ai][bj][m][1] * rsr);
#pragma unroll
                    for (int j = 0; j < 4; ++j) { a[j] = siluf_(a[j]); b[j] = siluf_(b[j]); }
                    *(u32x4*)(ZS + (size_t)row * DM + col) = pack8(a, b); } }
        } else if (pn < 11) {
            ROWLOOP { ROWDEF RSRDEF
#pragma unroll
                for (int bj = 0; bj < 2; ++bj) { const int col = (pn - 9) * 256 + bj * 128 + cw;
                    *(u32x4*)(XQ + (size_t)row * 512 + col) = pack8((acc[ai][bj][m][0] * rsr) * XSCALE, (acc[ai][bj][m][1] * rsr) * XSCALE); } }
        } else {
            ROWLOOP { ROWDEF RSRDEF
#pragma unroll
                for (int bj = 0; bj < 2; ++bj) { const int col = (pn - 11) * 256 + bj * 128 + cw;
                    f32x4 a = (acc[ai][bj][m][0] * rsr), b = (acc[ai][bj][m][1] * rsr);
#pragma unroll
                    for (int j = 0; j < 4; ++j) { a[j] = siluf_(a[j]); b[j] = siluf_(b[j]); }
                    *(u32x4*)(XZ + (size_t)row * 512 + col) = pack8(a, b); } }
        }
    }
};

struct Epi2 {
    static constexpr bool PERM = true, AFTER_DRAIN = false;
    const bf16_t* XB; bf16_t* X2;
    DI void operator()(const f32x4 (&acc)[2][2][4][2], const pg8::Unit& u, int wr, int wc, int fr, int fq) const {
        const int row0 = u.pm * 256 + wr * 64 + fr; const int cw = u.pn * 256 + wc * 32 + 8 * fq;
        ROWLOOP { ROWDEF
#pragma unroll
            for (int bj = 0; bj < 2; ++bj) { const size_t o = (size_t)row * DM + cw + bj * 128;
                const u32x4 r = *(const u32x4*)(XB + o);
                const f32x4 v0 = (f32x4){bflo(r.x), bfhi(r.x), bflo(r.y), bfhi(r.y)} + acc[ai][bj][m][0], v1 = (f32x4){bflo(r.z), bfhi(r.z), bflo(r.w), bfhi(r.w)} + acc[ai][bj][m][1];
                *(u32x4*)(X2 + o) = pack8(v0, v1); }
        }
    }
};

struct SplitOrder {
    int c;
    __device__ bool next(int i, pg8::Unit& u) const { if (i > 0 || c >= 64) return false; u.pm = 128 + (c >> 4); u.pn = (c >> 2) & 3; u.ko = (c & 3) * 384; u.ix = 0; return true; }
    DI void a_ready(const pg8::Unit&) const {}
    DI void done(const pg8::Unit&) const {}
};
struct OneTile {
    int pm, pn;
    __device__ bool next(int i, pg8::Unit& u) const { if (i > 0) return false; u.pm = pm; u.pn = pn; u.ko = 0; u.ix = 0; return true; }
    DI void a_ready(const pg8::Unit&) const {}
    DI void done(const pg8::Unit&) const {}
};
struct Order3 {
    int G, c;
    __device__ bool next(int i, pg8::Unit& u) const {
        const int L = i * G + c; if (L >= 1536) return false;
        const int wgid = (L & 7) * 192 + (L >> 3);
        if (wgid < 1248) { const int gid = wgid / 104, w = wgid % 104; u.pm = gid * 8 + (w & 7); u.pn = w >> 3; }
        else { const int w2 = wgid - 1248, gid = w2 / 72, w = w2 % 72; u.pm = 96 + gid * 8 + (w & 7); u.pn = w >> 3; }
        u.ko = 0; u.ix = i; return true;
    }
    DI void a_ready(const pg8::Unit&) const {}
    DI void done(const pg8::Unit&) const {}
};
struct EpiPart {
    static constexpr bool PERM = true, AFTER_DRAIN = false;
    float* part;
    DI void operator()(const f32x4 (&acc)[2][2][4][2], const pg8::Unit& u, int wr, int wc, int fr, int fq) const {
        const int row0 = (u.pm - 128) * 256 + wr * 64 + fr; const int cw = u.pn * 256 + wc * 32 + 8 * fq;
        float* base = part + (size_t)(u.ko / 384) * (TSMP * DM);
        ROWLOOP { ROWDEF
            float* dst = base + (size_t)row * DM;
#pragma unroll
            for (int bj = 0; bj < 2; ++bj) { *(f32x4*)(dst + cw + bj * 128) = acc[ai][bj][m][0]; *(f32x4*)(dst + cw + bj * 128 + 4) = acc[ai][bj][m][1]; }
        }
    }
};
struct Epi2a {
    static constexpr bool PERM = true, AFTER_DRAIN = false;
    const float* xp; bf16_t* XB; float* PS;
    DI void operator()(const f32x4 (&acc)[2][2][4][2], const pg8::Unit& u, int wr, int wc, int fr, int fq) const {
        const int row0 = u.pm * 256 + wr * 64 + fr; const int cw = u.pn * 256 + wc * 32 + 8 * fq;
        ROWLOOP { ROWDEF
            const float* src = xp + (size_t)row * DM; bf16_t* xb = XB + (size_t)row * DM;
            float ss = 0.f;
#pragma unroll
            for (int bj = 0; bj < 2; ++bj) { const int col = cw + bj * 128;
                const f32x4 v0 = *(const f32x4*)(src + col) + acc[ai][bj][m][0], v1 = *(const f32x4*)(src + col + 4) + acc[ai][bj][m][1];
                *(u32x4*)(xb + col) = pack8(v0, v1);
                ss += (v0[0] * v0[0] + v0[1] * v0[1]) + (v0[2] * v0[2] + v0[3] * v0[3]) + (v1[0] * v1[0] + v1[1] * v1[1]) + (v1[2] * v1[2] + v1[3] * v1[3]); }
            ss += __shfl_xor(ss, 16); ss += __shfl_xor(ss, 32);
            if (fq == 0) PS[(size_t)row * 16 + u.pn * 4 + wc] = ss;
            if (m & 1) asm volatile("" ::: "memory");
        }
    }
};
struct EpiM {
    static constexpr bool PERM = true, AFTER_DRAIN = false;
    bf16_t *MK, *MV; float* out;
    DI void operator()(const f32x4 (&acc)[2][2][4][2], const pg8::Unit& u, int wr, int wc, int fr, int fq) const {
        const int row0 = u.pm * 256 + wr * 64 + fr;
#pragma unroll
        for (int bj = 0; bj < 2; ++bj) { const int c = u.pn * 256 + bj * 128 + wc * 32 + 8 * fq; const int layer = c >> 10, e = c & 1023, isv = e >> 9, e2 = e & 511;
            ROWLOOP { ROWDEF  const size_t o = ((size_t)((layer * 2 + (row >> 8)) * 256 + (row & 255))) * 512 + e2;
                float* fo = out + (isv ? O_MVP : O_MKP) + o; bf16_t* bo = (isv ? MV : MK) + o;
                *(f32x4*)fo = acc[ai][bj][m][0]; *(f32x4*)(fo + 4) = acc[ai][bj][m][1];
                *(u32x4*)bo = pack8(acc[ai][bj][m][0], acc[ai][bj][m][1]);  } }
    }
};

DI int map_conv(int n) { if (n < 2048) { const int ch = n & 1023; return ((ch >> 7) << 8) + ((n >> 10) << 7) + (ch & 127); } return n; }
DI int ropepos(int d) { return 32 * ((d & 31) >> 4) + 8 * ((d >> 2) & 3) + 4 * (d >> 5) + (d & 3); }
DI int map_attn(int n) { if (n < 1152) return (n & ~63) + ropepos(n & 63); return n; }
template <int MAP> DI void transpose_item(const float* W, int K, int N, bf16_t* WT, LAS float* scr, int item, int lane, const float* gain = nullptr) {
    const int nblk = N / 32, kb = item / nblk, nb = item % nblk, k0 = 64 * kb, n0 = 32 * nb;
    float tv[32];
#pragma unroll
    for (int i = 0; i < 32; ++i) tv[i] = W[(size_t)(k0 + 2 * i + (lane >> 5)) * N + n0 + (lane & 31)];
#pragma unroll
    for (int i = 0; i < 32; ++i) scr[(2 * i + (lane >> 5)) * 33 + (lane & 31)] = tv[i];
    asm volatile("s_waitcnt lgkmcnt(0)" ::: "memory");
    const int c = lane & 7;
#pragma unroll
    for (int j = 0; j < 4; ++j) { const int n = (lane >> 3) + 8 * j; const LAS float* s = scr + (8 * c) * 33 + n;
        f32x4 g0 = {1.f, 1.f, 1.f, 1.f}, g1 = g0; if (gain) { g0 = *(const f32x4*)(gain + k0 + 8 * c); g1 = *(const f32x4*)(gain + k0 + 8 * c + 4); }
        u32x4 o; o.x = pk2(s[0 * 33] * g0[0], s[1 * 33] * g0[1]); o.y = pk2(s[2 * 33] * g0[2], s[3 * 33] * g0[3]); o.z = pk2(s[4 * 33] * g1[0], s[5 * 33] * g1[1]); o.w = pk2(s[6 * 33] * g1[2], s[7 * 33] * g1[3]);
        const int nn = n0 + n; const int dr = MAP == 1 ? map_conv(nn) : (MAP == 2 ? map_attn(nn) : nn);
        *(u32x4*)(WT + (size_t)dr * K + k0 + 8 * c) = o; }
    asm volatile("s_waitcnt lgkmcnt(0)" ::: "memory");
}
DI void rms_row_bf16(const float* xrow, const float* g, bf16_t* orow, int lane) {
    const f32x4* xr = (const f32x4*)xrow + lane; const f32x4* gr = (const f32x4*)g + lane;
    f32x4 v[4]; float s = 0.f;
#pragma unroll
    for (int j = 0; j < 4; ++j) { v[j] = xr[64 * j]; s += (v[j].x * v[j].x + v[j].y * v[j].y) + (v[j].z * v[j].z + v[j].w * v[j].w); }
    const float rstd = 1.0f / sqrtf(wave_sum(s) * (1.f / DM) + 1e-6f);
    u32x2* o8 = (u32x2*)orow + lane;
#pragma unroll
    for (int j = 0; j < 4; ++j) { const f32x4 gg = gr[64 * j]; u32x2 w; w.x = pk2(v[j].x * rstd * gg.x, v[j].y * rstd * gg.y); w.y = pk2(v[j].z * rstd * gg.z, v[j].w * rstd * gg.w); o8[64 * j] = w; }
}
DI void rms_row_final(const bf16_t* xrow, float* orow, const float* g, int lane, const float* part) {
    const u32x2* xr = (const u32x2*)xrow + lane; const f32x4* gr = (const f32x4*)g + lane; f32x4* o4 = (f32x4*)orow + lane;
    f32x4 v[4]; float s = 0.f;
#pragma unroll
    for (int j = 0; j < 4; ++j) { const u32x2 r = xr[64 * j]; v[j] = (f32x4){bflo(r.x), bfhi(r.x), bflo(r.y), bfhi(r.y)};
        if (part) {
#pragma unroll
            for (int ks = 0; ks < 4; ++ks) v[j] += ((const f32x4*)(part + (size_t)ks * TSMP * DM) + lane)[64 * j]; }
        s += (v[j].x * v[j].x + v[j].y * v[j].y) + (v[j].z * v[j].z + v[j].w * v[j].w); }
    const float rstd = 1.0f / sqrtf(wave_sum(s) * (1.f / DM) + 1e-6f);
#pragma unroll
    for (int j = 0; j < 4; ++j) { const f32x4 gg = gr[64 * j]; o4[64 * j] = v[j] * rstd * gg; }
}

template <int R> DI void rms_rows_bf16(const float* xp, const float* xs, int m0, int stride, const float* g, bf16_t* H, int lane) {
    f32x4 v[R][4];
#pragma unroll
    for (int k = 0; k < R; ++k) { const int mm = m0 + k * stride; const f32x4* xr = (const f32x4*)(mm < TP ? xp + (size_t)mm * DM : xs + (size_t)(mm - TP) * DM) + lane;
#pragma unroll
        for (int j = 0; j < 4; ++j) v[k][j] = xr[64 * j]; }
    f32x4 gg[4];
#pragma unroll
    for (int j = 0; j < 4; ++j) gg[j] = ((const f32x4*)g + lane)[64 * j];
#pragma unroll
    for (int k = 0; k < R; ++k) { float s = 0.f;
#pragma unroll
        for (int j = 0; j < 4; ++j) s += (v[k][j].x * v[k][j].x + v[k][j].y * v[k][j].y) + (v[k][j].z * v[k][j].z + v[k][j].w * v[k][j].w);
        const float rstd = 1.0f / sqrtf(wave_sum(s) * (1.f / DM) + 1e-6f);
        u32x2* o8 = (u32x2*)(H + (size_t)(m0 + k * stride) * DM) + lane;
#pragma unroll
        for (int j = 0; j < 4; ++j) { u32x2 w; w.x = pk2(v[k][j].x * rstd * gg[j].x, v[k][j].y * rstd * gg[j].y); w.y = pk2(v[k][j].z * rstd * gg[j].z, v[k][j].w * rstd * gg[j].w); o8[64 * j] = w; } }
}
template <int R> DI void rms_rows_final(const bf16_t* X2, float* out, int m0, int stride, const float* g, int lane) {
    u32x2 rr[R][4];
#pragma unroll
    for (int k = 0; k < R; ++k) { const u32x2* xr = (const u32x2*)(X2 + (size_t)(m0 + k * stride) * DM) + lane;
#pragma unroll
        for (int j = 0; j < 4; ++j) rr[k][j] = xr[64 * j]; }
    f32x4 gg[4];
#pragma unroll
    for (int j = 0; j < 4; ++j) gg[j] = ((const f32x4*)g + lane)[64 * j];
#pragma unroll
    for (int k = 0; k < R; ++k) { f32x4 v[4]; float s = 0.f;
#pragma unroll
        for (int j = 0; j < 4; ++j) { v[j] = (f32x4){bflo(rr[k][j].x), bfhi(rr[k][j].x), bflo(rr[k][j].y), bfhi(rr[k][j].y)}; s += (v[j].x * v[j].x + v[j].y * v[j].y) + (v[j].z * v[j].z + v[j].w * v[j].w); }
        const float rstd = 1.0f / sqrtf(wave_sum(s) * (1.f / DM) + 1e-6f);
        f32x4* o4 = (f32x4*)(out + (size_t)(m0 + k * stride) * DM) + lane;
#pragma unroll
        for (int j = 0; j < 4; ++j) o4[64 * j] = v[j] * rstd * gg[j]; }
}

DI void prologue(const Args& a, LAS unsigned char* lds, int G) {
    const int tid = threadIdx.x, lane = tid & 63, wave = __builtin_amdgcn_readfirstlane(tid >> 6);
    LAS float* scr = (LAS float*)(lds + wave * 16384);
    const int gw = blockIdx.x * 8 + wave, NGW = G * 8;
    unsigned char* ws = a.ws;
    constexpr int I_C = 16 * 128, I_A = 16 * 104, I_O = 24 * 32, I_M = 16 * 32;
    constexpr int NITEMS = I_C + I_A + 2 * I_O + 2 * I_M;
    for (int it = gw; it < NITEMS; it += NGW) {
        int r = it;
        if (r < I_C) { transpose_item<1>(a.in[9], 1024, 4096, (bf16_t*)(ws + WS_WC), scr, r, lane); continue; } r -= I_C;
        if (r < I_A) { transpose_item<2>(a.in[14], 1024, 3328, (bf16_t*)(ws + WS_WA), scr, r, lane, a.in[8] + DM); continue; } r -= I_A;
        if (r < 2 * I_O) { const int l = r / I_O; transpose_item<0>(a.in[17] + (size_t)l * 1536 * 1024, 1536, 1024, (bf16_t*)(ws + WS_WO) + (size_t)l * 1024 * 1536, scr, r % I_O, lane); continue; } r -= 2 * I_O;
        { const int l = r / I_M; transpose_item<0>(a.in[16] + (size_t)l * 1024 * 1024, 1024, 1024, (bf16_t*)(ws + WS_WM) + (size_t)l * 1024 * 1024, scr, r % I_M, lane); }
    }
    bf16_t* H = (bf16_t*)(ws + WS_H);
    { int m = gw;
      for (; m + 3 * NGW < TT; m += 4 * NGW) rms_rows_bf16<4>(a.in[0], a.in[1], m, NGW, a.in[8], H, lane);
      for (; m < TT; m += NGW) rms_rows_bf16<1>(a.in[0], a.in[1], m, NGW, a.in[8], H, lane); }
    const int gt = blockIdx.x * NTHR + tid, NGT = G * NTHR;
    { bf16_t* MP = (bf16_t*)(ws + WS_MP); for (int i = gt; i < 512 * 1024 / 8; i += NGT) *(u32x4*)(MP + (size_t)i * 8) = pack8f(a.in[7] + (size_t)i * 8); }
    for (int i = gt; i < 2 * 16 * 2048; i += NGT) { const int which = i >> 15, r = i & 32767, b = r >> 11, o = r & 2047;
        const f32x4 v = *(const f32x4*)(a.in[3 + which] + (size_t)(b * 128 + 64) * 128 + o * 4);
        *(f32x4*)(a.out + (which ? O_VS : O_KS) + (size_t)(b * 128) * 128 + o * 4) = v; }
}

#define MFMA32(a, b, c) __builtin_amdgcn_mfma_f32_32x32x16_bf16((a), (b), (c), 0, 0, 0)
typedef short v4i16_t __attribute__((ext_vector_type(4)));
DI s16x4 v_tr(const LAS unsigned char* p) { return __builtin_bit_cast(s16x4, __builtin_amdgcn_ds_read_tr16_b64_v4i16((LAS v4i16_t*)p)); }
DI int v_lane_off(int r, int h) { const int lane = r + 32 * h; return ((lane >> 4) & 1) * 32 + (lane & 3) * 8 + (4 * h + ((lane & 15) >> 2)) * 64; }
template <int NKT, int NDS, int NDT, int KSTR, int VSTR, bool SINK>
DI void attn_core(const LAS unsigned char* Kl, const LAS unsigned char* Vl, const bf16x8 (&qf)[NDS], int kt0, float sink, f32x16 (&o)[NDT], float& rl, int r, int h) {
    f32x16 s[NKT];
#pragma unroll
    for (int kt = 0; kt < NKT; ++kt) {
        if (kt >= kt0) {
#pragma unroll
            for (int i = 0; i < 16; ++i) s[kt][i] = 0.f;
#pragma unroll
            for (int ds = 0; ds < NDS; ++ds) { const bf16x8 ka = *(const LAS bf16x8*)(Kl + (kt * 32 + r) * KSTR + ds * 32 + h * 16); s[kt] = MFMA32(ka, qf[ds], s[kt]); }
        } else {
#pragma unroll
            for (int i = 0; i < 16; ++i) s[kt][i] = -INFINITY;
        }
    }
    float m = -INFINITY;
#pragma unroll
    for (int kt = 0; kt < NKT; ++kt)
#pragma unroll
        for (int i = 0; i < 16; ++i) m = fmaxf(m, s[kt][i]);
    m = fmaxf(m, __shfl_xor(m, 32));
    if (SINK) m = fmaxf(m, sink);
    float l = 0.f;
#pragma unroll
    for (int kt = 0; kt < NKT; ++kt)
#pragma unroll
        for (int i = 0; i < 16; ++i) { s[kt][i] = __builtin_amdgcn_exp2f(s[kt][i] - m); l += s[kt][i]; }
    l += __shfl_xor(l, 32);
    if (SINK) l += __builtin_amdgcn_exp2f(sink - m);
    rl = 1.0f / l;
#pragma unroll
    for (int dt = 0; dt < NDT; ++dt)
#pragma unroll
        for (int i = 0; i < 16; ++i) o[dt][i] = 0.f;
#pragma unroll
    for (int kt = 0; kt < NKT; ++kt) {
        if (kt >= kt0) {
#pragma unroll
            for (int st = 0; st < 2; ++st) {
                u32x4 pw; pw.x = pk2(s[kt][8 * st + 0], s[kt][8 * st + 1]); pw.y = pk2(s[kt][8 * st + 2], s[kt][8 * st + 3]); pw.z = pk2(s[kt][8 * st + 4], s[kt][8 * st + 5]); pw.w = pk2(s[kt][8 * st + 6], s[kt][8 * st + 7]);
                const bf16x8 pb = __builtin_bit_cast(bf16x8, pw);
#pragma unroll
                for (int dt = 0; dt < NDT; ++dt) {
                    const LAS unsigned char* vp = Vl + dt * VSTR + (kt * 32 + 16 * st) * 64 + v_lane_off(r, h);
                    const s16x4 lo = v_tr(vp), hi = v_tr(vp + 512);
                    const bf16x8 va = __builtin_shufflevector(lo, hi, 0, 1, 2, 3, 4, 5, 6, 7);
                    o[dt] = MFMA32(va, pb, o[dt]);
                }
            }
        }
    }
}
template <int NDS, int KSTR> DI void ld_kfrag(bf16x8 (&ka)[NDS], const LAS unsigned char* Kl, int kt, int r, int h) {
#pragma unroll
    for (int ds = 0; ds < NDS; ++ds) ka[ds] = *(const LAS bf16x8*)(Kl + (kt * 32 + r) * KSTR + ds * 32 + h * 16);
}
template <int NKT, int NDS, int NDT, int KSTR, int VSTR, bool SINK>
DI void attn_core3(const LAS unsigned char* Kl, const LAS unsigned char* Vl, const bf16x8 (&qf)[NDS], int kt0, float sink, f32x16 (&o)[NDT], float& rl, int r, int h, const bf16_t* zp = nullptr, int zstride = 0, u32x4* zv = nullptr) {
    float m = -INFINITY;
    const int ktb = SINK ? kt0 : 0;
    bf16x8 ka[NDS];
    ld_kfrag<NDS, KSTR>(ka, Kl, ktb, r, h);
#pragma unroll
    for (int kt = 0; kt < NKT; ++kt) {
        if (!SINK || kt >= kt0) {
            f32x16 s;
#pragma unroll
            for (int i = 0; i < 16; ++i) s[i] = 0.f;
#pragma unroll
            for (int ds = 0; ds < NDS; ++ds) s = MFMA32(ka[ds], qf[ds], s);
            asm volatile("" ::: "memory");
            if (kt + 1 < NKT) ld_kfrag<NDS, KSTR>(ka, Kl, kt + 1, r, h);
#pragma unroll
            for (int i = 0; i < 16; ++i) m = fmaxf(m, s[i]);
            asm volatile("" ::: "memory");
        }
    }
    if (zp) {
#pragma unroll
        for (int i = 0; i < 4; ++i) zv[i] = *(const u32x4*)(zp + (size_t)i * zstride); }
    m = fmaxf(m, __shfl_xor(m, 32));
    if (SINK) m = fmaxf(m, sink);
    asm volatile("" : "+v"(m) :: "memory");
    float l = 0.f;
#pragma unroll
    for (int dt = 0; dt < NDT; ++dt)
#pragma unroll
        for (int i = 0; i < 16; ++i) o[dt][i] = 0.f;
    ld_kfrag<NDS, KSTR>(ka, Kl, ktb, r, h);
#pragma unroll
    for (int kt = 0; kt < NKT; ++kt) {
        if (!SINK || kt >= kt0) {
            bf16x8 va[2][NDT];
#pragma unroll
            for (int st = 0; st < 2; ++st)
#pragma unroll
                for (int dt = 0; dt < NDT; ++dt) {
                    const LAS unsigned char* vp = Vl + dt * VSTR + (kt * 32 + 16 * st) * 64 + v_lane_off(r, h);
                    const s16x4 lo = v_tr(vp), hi = v_tr(vp + 512);
                    va[st][dt] = __builtin_shufflevector(lo, hi, 0, 1, 2, 3, 4, 5, 6, 7); }
            f32x16 s;
#pragma unroll
            for (int i = 0; i < 16; ++i) s[i] = -m;
#pragma unroll
            for (int ds = 0; ds < NDS; ++ds) s = MFMA32(ka[ds], qf[ds], s);
            asm volatile("" ::: "memory");
            if (kt + 1 < NKT) ld_kfrag<NDS, KSTR>(ka, Kl, kt + 1, r, h);
#pragma unroll
            for (int i = 0; i < 16; ++i) { s[i] = __builtin_amdgcn_exp2f(s[i]); l += s[i]; }
#pragma unroll
            for (int st = 0; st < 2; ++st) {
                u32x4 pw; pw.x = pk2(s[8 * st + 0], s[8 * st + 1]); pw.y = pk2(s[8 * st + 2], s[8 * st + 3]); pw.z = pk2(s[8 * st + 4], s[8 * st + 5]); pw.w = pk2(s[8 * st + 6], s[8 * st + 7]);
                const bf16x8 pb = __builtin_bit_cast(bf16x8, pw);
#pragma unroll
                for (int dt = 0; dt < NDT; ++dt) o[dt] = MFMA32(va[st][dt], pb, o[dt]);
            }
            asm volatile("" ::: "memory");
        }
    }
    l += __shfl_xor(l, 32);
    if (SINK) l += __builtin_amdgcn_exp2f(sink - m);
    rl = 1.0f / l;
}
template <int NKT, int NDS, int NDT, int KSTR, int VSTR, bool SINK>
DI void attn_core2(const LAS unsigned char* Kl, const LAS unsigned char* Vl, const bf16x8 (&qf)[NDS], int kt0, float sink, f32x16 (&o)[NDT], float& rl, int r, int h) {
    float m = -INFINITY;
#pragma unroll
    for (int kt = 0; kt < NKT; ++kt) {
        if (SINK && kt < kt0) continue;
        f32x16 s;
#pragma unroll
        for (int i = 0; i < 16; ++i) s[i] = 0.f;
#pragma unroll
        for (int ds = 0; ds < NDS; ++ds) { const bf16x8 ka = *(const LAS bf16x8*)(Kl + (kt * 32 + r) * KSTR + ds * 32 + h * 16); s = MFMA32(ka, qf[ds], s); }
#pragma unroll
        for (int i = 0; i < 16; ++i) m = fmaxf(m, s[i]);
    }
    m = fmaxf(m, __shfl_xor(m, 32));
    if (SINK) m = fmaxf(m, sink);
    asm volatile("" : "+v"(m) :: "memory");
    float l = 0.f;
#pragma unroll
    for (int dt = 0; dt < NDT; ++dt)
#pragma unroll
        for (int i = 0; i < 16; ++i) o[dt][i] = 0.f;
#pragma unroll
    for (int kt = 0; kt < NKT; ++kt) {
        if (SINK && kt < kt0) continue;
        f32x16 s;
#pragma unroll
        for (int i = 0; i < 16; ++i) s[i] = -m;
#pragma unroll
        for (int ds = 0; ds < NDS; ++ds) { const bf16x8 ka = *(const LAS bf16x8*)(Kl + (kt * 32 + r) * KSTR + ds * 32 + h * 16); s = MFMA32(ka, qf[ds], s); }
#pragma unroll
        for (int i = 0; i < 16; ++i) { s[i] = __builtin_amdgcn_exp2f(s[i]); l += s[i]; }
#pragma unroll
        for (int st = 0; st < 2; ++st) {
            u32x4 pw; pw.x = pk2(s[8 * st + 0], s[8 * st + 1]); pw.y = pk2(s[8 * st + 2], s[8 * st + 3]); pw.z = pk2(s[8 * st + 4], s[8 * st + 5]); pw.w = pk2(s[8 * st + 6], s[8 * st + 7]);
            const bf16x8 pb = __builtin_bit_cast(bf16x8, pw);
#pragma unroll
            for (int dt = 0; dt < NDT; ++dt) {
                const LAS unsigned char* vp = Vl + dt * VSTR + (kt * 32 + 16 * st) * 64 + v_lane_off(r, h);
                const s16x4 lo = v_tr(vp), hi = v_tr(vp + 512);
                const bf16x8 va = __builtin_shufflevector(lo, hi, 0, 1, 2, 3, 4, 5, 6, 7);
                o[dt] = MFMA32(va, pb, o[dt]);
            }
        }
        asm volatile("" ::: "memory");
    }
    l += __shfl_xor(l, 32);
    if (SINK) l += __builtin_amdgcn_exp2f(sink - m);
    rl = 1.0f / l;
}
DI void vt_write8(LAS unsigned char* Vl, int vstr, int d0, int key, u32x4 v) {
    LAS unsigned short* p = (LAS unsigned short*)(Vl + d0 * vstr + key * 2); const int st = vstr / 2;
    p[0 * st] = (unsigned short)(v.x & 0xffff); p[1 * st] = (unsigned short)(v.x >> 16); p[2 * st] = (unsigned short)(v.y & 0xffff); p[3 * st] = (unsigned short)(v.y >> 16);
    p[4 * st] = (unsigned short)(v.z & 0xffff); p[5 * st] = (unsigned short)(v.z >> 16); p[6 * st] = (unsigned short)(v.w & 0xffff); p[7 * st] = (unsigned short)(v.w >> 16);
}

constexpr int MEM_KSTR = 272, MEM_VSTR = 256 * 64, MEM_VOFF = 256 * MEM_KSTR;
DI void memattn_unit(const Args& a, LAS unsigned char* lds, int layer, int unit) {
    const int tid = threadIdx.x, lane = tid & 63, w = __builtin_amdgcn_readfirstlane(tid >> 6), r = lane & 31, h = lane >> 5;
    unsigned char* ws = a.ws;
    int b, hd, tok0, ntok; bool sample;
    if (unit < 512) { b = unit >> 8; hd = (unit >> 6) & 3; tok0 = b * 16384 + (unit & 63) * 256; ntok = 256; sample = false; }
    else { const int s = unit - 512; b = s >> 2; hd = s & 3; tok0 = TP + b * 64; ntok = 64; sample = true; }
    LAS unsigned char* Kl = lds; LAS unsigned char* Vl = lds + MEM_VOFF;
    const bool act = w * 32 < ntok;
    const bf16_t* XZ = (const bf16_t*)(ws + WS_XZ); bf16_t* A2 = (bf16_t*)(ws + WS_A2);
    bf16x8 qf[8]; u32x4 zv[8];
    if (!sample) {
        const bf16_t* Kg = (const bf16_t*)(ws + WS_MK) + ((size_t)(layer * 2 + b) * 256) * 512 + hd * 128;
        const bf16_t* Vg = (const bf16_t*)(ws + WS_MV) + ((size_t)(layer * 2 + b) * 256) * 512 + hd * 128;
        u32x4 kk[8], vv[8];
#pragma unroll
        for (int it = 0; it < 8; ++it) { const int ci = tid + NTHR * it;
            kk[it] = *(const u32x4*)(Kg + (size_t)(ci >> 4) * 512 + (ci & 15) * 8);
            vv[it] = *(const u32x4*)(Vg + (size_t)(ci >> 4) * 512 + (ci & 15) * 8); }
        { const bf16_t* qp = (const bf16_t*)(ws + WS_XQ) + ((size_t)tok0 + w * 32 + r) * 512 + hd * 128 + h * 8;
#pragma unroll
            for (int ds = 0; ds < 8; ++ds) qf[ds] = *(const bf16x8*)(qp + ds * 16); }
#pragma unroll
        for (int it = 0; it < 8; ++it) { const int ci = tid + NTHR * it;
            *(LAS u32x4*)(Kl + (ci >> 4) * MEM_KSTR + (ci & 15) * 16) = kk[it];
            *(LAS u32x4*)(Vl + ((ci & 15) >> 2) * MEM_VSTR + (ci >> 4) * 64 + (ci & 3) * 16) = vv[it]; }
    } else {
        const float* Kg = a.in[5] + ((size_t)(layer * 16 + b) * 256) * 512 + hd * 128;
        const float* Vg = a.in[6] + ((size_t)(layer * 16 + b) * 256) * 512 + hd * 128;
        if (act) { const bf16_t* qp = (const bf16_t*)(ws + WS_XQ) + ((size_t)tok0 + w * 32 + r) * 512 + hd * 128 + h * 8;
#pragma unroll
            for (int ds = 0; ds < 8; ++ds) qf[ds] = *(const bf16x8*)(qp + ds * 16); }
#pragma unroll 4
        for (int it = 0; it < 8; ++it) { const int ci = tid + NTHR * it;
            { const int key = ci >> 4, c8 = ci & 15; *(LAS u32x4*)(Kl + key * MEM_KSTR + c8 * 16) = pack8f(Kg + (size_t)key * 512 + c8 * 8); }
            { const int key = ci >> 4, c8 = ci & 15; *(LAS u32x4*)(Vl + (c8 >> 2) * MEM_VSTR + key * 64 + (c8 & 3) * 16) = pack8f(Vg + (size_t)key * 512 + c8 * 8); } }
    }
    __syncthreads();
    u32x2 ost[16];
    if (act) {
        f32x16 o[4]; float rl;
        attn_core2<8, 8, 4, MEM_KSTR, MEM_VSTR, false>(Kl, Vl, qf, 0, 0.f, o, rl, r, h);
#pragma unroll
        for (int i = 0; i < 8; ++i) zv[i] = *(const u32x4*)(XZ + ((size_t)tok0 + w * 32 + i * 4 + (lane >> 4)) * 512 + hd * 128 + (lane & 15) * 8);
#pragma unroll
        for (int dt = 0; dt < 4; ++dt)
#pragma unroll
            for (int g = 0; g < 4; ++g) { ost[dt * 4 + g].x = pk2(o[dt][4 * g + 0] * rl, o[dt][4 * g + 1] * rl); ost[dt * 4 + g].y = pk2(o[dt][4 * g + 2] * rl, o[dt][4 * g + 3] * rl); }
    }
    __syncthreads();
    if (act) {
        LAS unsigned char* stg = lds + w * (32 * MEM_KSTR);
#pragma unroll
        for (int dt = 0; dt < 4; ++dt)
#pragma unroll
            for (int g = 0; g < 4; ++g) *(LAS u32x2*)(stg + r * MEM_KSTR + (dt * 32 + 8 * g + 4 * h) * 2) = ost[dt * 4 + g];
#pragma unroll
        for (int i = 0; i < 8; ++i) { const int row = i * 4 + (lane >> 4), ch = lane & 15; const size_t tk = (size_t)tok0 + w * 32 + row;
            const u32x4 ov = *(const LAS u32x4*)(stg + row * MEM_KSTR + ch * 16); const u32x4 z4 = zv[i];
            u32x4 rv; rv.x = pk2(bflo(ov.x) * bflo(z4.x), bfhi(ov.x) * bfhi(z4.x)); rv.y = pk2(bflo(ov.y) * bflo(z4.y), bfhi(ov.y) * bfhi(z4.y));
            rv.z = pk2(bflo(ov.z) * bflo(z4.z), bfhi(ov.z) * bfhi(z4.z)); rv.w = pk2(bflo(ov.w) * bflo(z4.w), bfhi(ov.w) * bfhi(z4.w));
            *(u32x4*)(A2 + tk * 1536 + 1024 + hd * 128 + ch * 8) = rv; }
    }
    __syncthreads();
}

constexpr int SWA_KSTR = 144, SWA_VSTR = 192 * 64, SWA_VOFF = 192 * SWA_KSTR, SWA_STG_OFF = 53248;
struct SwaPre { u32x4 kv[3], vv[3]; bf16x8 qf[4]; };
DI void swa_decode(int unit, int& b, int& kvh, int& tok0, int& kt0, bool& sample) {
    if (unit < 1024) { const int k = unit >> 8, cb = unit & 255; b = k >> 1; kvh = k & 1; const int c = (cb & 7) * 32 + (cb >> 3);
        tok0 = b * 16384 + c * 64; kt0 = c >= 2 ? 0 : (2 - c) * 2; sample = false; }
    else { const int s = unit - 1024; b = s >> 1; kvh = s & 1; tok0 = TP + b * 64; kt0 = 0; sample = true; }
}
DI void swa_issue(const Args& a, int unit, SwaPre& P) {
    const int tid = threadIdx.x, lane = tid & 63, w = __builtin_amdgcn_readfirstlane(tid >> 6), r = lane & 31, h = lane >> 5;
    unsigned char* ws = a.ws;
    int b, kvh, tok0, kt0; bool sample; swa_decode(unit, b, kvh, tok0, kt0, sample);
    const bf16_t* KB = (const bf16_t*)(ws + WS_K); const bf16_t* VB = (const bf16_t*)(ws + WS_V);
    if (!sample) {
        const int tmin = b * 16384;
#pragma unroll
        for (int it = 0; it < 3; ++it) { const int ci = tid + NTHR * it;
            { const int key = ci >> 3, c8 = ci & 7; int tk = tok0 - 128 + key; tk = tk < tmin ? tmin : tk; P.kv[it] = *(const u32x4*)(KB + (size_t)tk * 128 + kvh * 64 + c8 * 8); }
            { const int key = ci >> 3, c8 = ci & 7; int tk = tok0 - 128 + key; tk = tk < tmin ? tmin : tk; P.vv[it] = *(const u32x4*)(VB + (size_t)tk * 128 + kvh * 64 + c8 * 8); } }
    } else {
#pragma unroll
        for (int it = 0; it < 3; ++it) { const int ci = tid + NTHR * it;
            { const int key = ci >> 3, c8 = ci & 7;
                if (key < 128) P.kv[it] = pack8f(a.in[3] + ((size_t)(b * 128 + key) * 2 + kvh) * 64 + c8 * 8);
                else P.kv[it] = *(const u32x4*)(KB + (size_t)(tok0 - 128 + key) * 128 + kvh * 64 + c8 * 8); }
            { const int key = ci >> 3, c8 = ci & 7;
                if (key < 128) P.vv[it] = pack8f(a.in[4] + ((size_t)(b * 128 + key) * 2 + kvh) * 64 + c8 * 8);
                else P.vv[it] = *(const u32x4*)(VB + (size_t)(tok0 - 128 + key) * 128 + kvh * 64 + c8 * 8); } }
    }
    const int head = kvh * 8 + w;
    { const bf16_t* qp = (const bf16_t*)(ws + WS_U) + ((size_t)tok0 + r) * DM + head * 64 + h * 8;
#pragma unroll
        for (int ds = 0; ds < 4; ++ds) P.qf[ds] = *(const bf16x8*)(qp + ds * 16); }
}
DI void swa_phase(const Args& a, LAS unsigned char* lds, int first, int stride, int nunits) {
    const int tid = threadIdx.x, lane = tid & 63, w = __builtin_amdgcn_readfirstlane(tid >> 6), r = lane & 31, h = lane >> 5;
    unsigned char* ws = a.ws;
    LAS unsigned char* Kl = lds; LAS unsigned char* Vl = lds + SWA_VOFF;
    const bf16_t* ZS = (const bf16_t*)(ws + WS_Z); bf16_t* A2 = (bf16_t*)(ws + WS_A2);
    if (first >= nunits) return;
    SwaPre P; swa_issue(a, first, P);
#pragma unroll 1
    for (int unit = first; unit < nunits; unit += stride) {
        int b, kvh, tok0, kt0; bool sample; swa_decode(unit, b, kvh, tok0, kt0, sample);
        const int head = kvh * 8 + w;
#pragma unroll
        for (int it = 0; it < 3; ++it) { const int ci = tid + NTHR * it;
            { const int key = ci >> 3, c8 = ci & 7; *(LAS u32x4*)(Kl + key * SWA_KSTR + c8 * 16) = P.kv[it]; }
            { const int key = ci >> 3, c8 = ci & 7; *(LAS u32x4*)(Vl + (c8 >> 2) * SWA_VSTR + key * 64 + (c8 & 3) * 16) = P.vv[it]; } }
        bf16x8 qf[2][4];
#pragma unroll
        for (int ds = 0; ds < 4; ++ds) qf[0][ds] = P.qf[ds];
        __syncthreads();
        if (unit + stride < nunits) swa_issue(a, unit + stride, P);
        { const bf16_t* qp = (const bf16_t*)(ws + WS_U) + ((size_t)tok0 + 32 + r) * DM + head * 64 + h * 8;
#pragma unroll
            for (int ds = 0; ds < 4; ++ds) qf[1][ds] = *(const bf16x8*)(qp + ds * 16); }
        u32x4 zv[2][4];
        const float sink = a.in[15][head] * LOG2E;
#pragma unroll
        for (int qb = 0; qb < 2; ++qb) {
            f32x16 o[2]; float rl;
            attn_core3<6, 4, 2, SWA_KSTR, SWA_VSTR, true>(Kl, Vl, qf[qb], kt0, sink, o, rl, r, h,
                ZS + ((size_t)tok0 + qb * 32 + (lane >> 3)) * DM + head * 64 + (lane & 7) * 8, 8 * DM, zv[qb]);
            LAS unsigned char* stg = lds + SWA_STG_OFF + w * (32 * 144);
#pragma unroll
            for (int dt = 0; dt < 2; ++dt)
#pragma unroll
                for (int g = 0; g < 4; ++g) { u32x2 ov; ov.x = pk2(o[dt][4 * g + 0] * rl, o[dt][4 * g + 1] * rl); ov.y = pk2(o[dt][4 * g + 2] * rl, o[dt][4 * g + 3] * rl);
                    *(LAS u32x2*)(stg + r * 144 + (dt * 32 + 8 * g + 4 * h) * 2) = ov; }
#pragma unroll
            for (int i = 0; i < 4; ++i) { const int row = i * 8 + (lane >> 3), ch = lane & 7; const size_t tk = (size_t)tok0 + qb * 32 + row;
                const u32x4 ov = *(const LAS u32x4*)(stg + row * 144 + ch * 16); const u32x4 z4 = zv[qb][i];
                u32x4 rv; rv.x = pk2(bflo(ov.x) * bflo(z4.x), bfhi(ov.x) * bfhi(z4.x)); rv.y = pk2(bflo(ov.y) * bflo(z4.y), bfhi(ov.y) * bfhi(z4.y));
                rv.z = pk2(bflo(ov.z) * bflo(z4.z), bfhi(ov.z) * bfhi(z4.z)); rv.w = pk2(bflo(ov.w) * bflo(z4.w), bfhi(ov.w) * bfhi(z4.w));
                *(u32x4*)(A2 + tk * 1536 + head * 64 + ch * 8) = rv; }
            asm volatile("" ::: "memory");
        }
        __syncthreads();
    }
}

template <int I> DI void conv_row(f32x2 (&acc)[32], const f32x2 (&wk)[31], const LAS unsigned char* lds, int rb, int tid) {
    const unsigned uv = *(const LAS unsigned*)(lds + ((rb + I) & 63) * 2048 + tid * 4); const f32x2 uf = {bflo(uv), bfhi(uv)};
    constexpr int T0 = I > 30 ? I - 30 : 0, T1 = I < 31 ? I : 31;
#pragma unroll
    for (int t = T0; t <= T1; ++t) acc[t] += wk[I - t] * uf;
    if constexpr ((I & 3) == 3) asm volatile("" ::: "memory");
    if constexpr (I + 1 < 62) conv_row<I + 1>(acc, wk, lds, rb, tid);
}
constexpr int CONV_RED_OFF = 131072, CONV_STAT_OFF = 131072 + 2048;
DI void conv_run(const Args& a, LAS unsigned char* lds, bool sample, int b, int tile0, int ntiles, const f32x2 (&wk)[31], const f32x2 cb, const f32x2 lg, const f32x2 lb) {
    const int tid = threadIdx.x, lane = tid & 63, w = __builtin_amdgcn_readfirstlane(tid >> 6);
    unsigned char* ws = a.ws;
    const int tfirst0 = tile0 * 32; const int tokbase0 = (sample ? TP + b * 64 : b * 16384) + tfirst0;
    const bf16_t* U = (const bf16_t*)(ws + WS_U); const bf16_t* ZS = (const bf16_t*)(ws + WS_Z); bf16_t* A2 = (bf16_t*)(ws + WS_A2);
    const int prow = tid >> 7, pc = tid & 127;
    u32x4 nw[8];
    {
        const bf16_t* np = U + (size_t)(tokbase0 + prow) * DM + pc * 8;
#pragma unroll
        for (int it = 0; it < 8; ++it) nw[it] = *(const u32x4*)(np + (size_t)it * 4 * DM);
        if (tfirst0 >= 32) {
            const bf16_t* hp = U + (size_t)(tokbase0 - 30 + prow) * DM + pc * 8; u32x4 hv[8];
#pragma unroll
            for (int it = 0; it < 7; ++it) hv[it] = *(const u32x4*)(hp + (size_t)it * 4 * DM);
            if (prow < 2) hv[7] = *(const u32x4*)(hp + (size_t)7 * 4 * DM);
#pragma unroll
            for (int it = 0; it < 7; ++it) *(LAS u32x4*)(lds + (it * 4 + prow) * 2048 + pc * 16) = hv[it];
            if (prow < 2) *(LAS u32x4*)(lds + (28 + prow) * 2048 + pc * 16) = hv[7];
        } else {
            for (int idx = tid; idx < 30 * 128; idx += NTHR) { const int i = idx >> 7, c = idx & 127; u32x4 v;
                if (sample) v = pack8f(a.in[2] + ((size_t)(b * 30 + i)) * DM + c * 8); else v = (u32x4){0u, 0u, 0u, 0u};
                *(LAS u32x4*)(lds + i * 2048 + c * 16) = v; }
        }
#pragma unroll
        for (int it = 0; it < 8; ++it) *(LAS u32x4*)(lds + (30 + it * 4 + prow) * 2048 + pc * 16) = nw[it];
    }
    __syncthreads();
#pragma unroll 1
    for (int j = 0; j < ntiles; ++j) {
        const int rb = (32 * j) & 63; const int tokbase = tokbase0 + 32 * j; const bool more = j + 1 < ntiles;
        if (more) { const bf16_t* np = U + (size_t)(tokbase + 32 + prow) * DM + pc * 8;
#pragma unroll
            for (int it = 0; it < 8; ++it) nw[it] = *(const u32x4*)(np + (size_t)it * 4 * DM); }
        f32x2 acc[32];
#pragma unroll
        for (int t = 0; t < 32; ++t) acc[t] = cb;
        conv_row<0>(acc, wk, lds, rb, tid);
        __syncthreads();
        if (more) {
#pragma unroll
            for (int it = 0; it < 8; ++it) *(LAS u32x4*)(lds + ((rb + 62 + it * 4 + prow) & 63) * 2048 + pc * 16) = nw[it]; }
        float vals[64];
#pragma unroll
        for (int t = 0; t < 32; ++t) { vals[t] = acc[t].x + acc[t].y; vals[32 + t] = acc[t].x * acc[t].x + acc[t].y * acc[t].y; }
#define BFLY(off) { const bool up = (lane & (off)) != 0; _Pragma("unroll") for (int jj = 0; jj < (off); ++jj) { const float send = up ? vals[jj] : vals[jj + (off)]; const float keep = up ? vals[jj + (off)] : vals[jj]; vals[jj] = keep + __shfl_xor(send, (off)); } }
        BFLY(32) BFLY(16) BFLY(8) BFLY(4) BFLY(2) BFLY(1)
#undef BFLY
        LAS float* red = (LAS float*)(lds + CONV_RED_OFF); LAS f32x2* stat = (LAS f32x2*)(lds + CONV_STAT_OFF);
        red[w * 64 + lane] = vals[0];
        asm volatile("" ::: "memory");
        unsigned zq[32];
#pragma unroll
        for (int t = 0; t < 32; ++t) zq[t] = *(const unsigned*)(ZS + (size_t)(tokbase + t) * DM + 2 * tid);
        __syncthreads();
        if (tid < 32) { float s1 = 0.f, s2 = 0.f;
#pragma unroll
            for (int ww = 0; ww < 8; ++ww) { s1 += red[ww * 64 + tid]; s2 += red[ww * 64 + 32 + tid]; }
            const float mean = s1 * (1.f / DM); const float var = fmaxf(s2 * (1.f / DM) - mean * mean, 0.f);
            stat[tid] = (f32x2){mean, 1.0f / sqrtf(var + 1e-5f)}; }
        __syncthreads();
#pragma unroll
        for (int t = 0; t < 32; ++t) { const f32x2 st = stat[t]; const unsigned zv = zq[t];
            const float y0 = (acc[t].x - st.x) * st.y * lg.x + lb.x, y1 = (acc[t].y - st.x) * st.y * lg.y + lb.y;
            *(unsigned*)(A2 + (size_t)(tokbase + t) * 1536 + 2 * tid) = pk2(siluf_(y0) * bflo(zv), siluf_(y1) * bfhi(zv)); }
    }
    __syncthreads();
}

#define XB_TMO      128
#define XB_XCNT(j)  (256  + 64 * (j))
#define XB_XSUB(j)  (1280 + 64 * (j))
#define XB_XGEN(j)  (2304 + 64 * (j))
#define XB_TOP      3328
#define XB_TOPGEN   3392
#define XCD_BAR_WORDS 3456
#define XB_SPIN_CAP (1u << 18)

__device__ __forceinline__ unsigned xb_ld(unsigned* p)              { return __hip_atomic_load(p, __ATOMIC_RELAXED, __HIP_MEMORY_SCOPE_AGENT); }
__device__ __forceinline__ unsigned xb_add(unsigned* p, unsigned v) { return __hip_atomic_fetch_add(p, v, __ATOMIC_RELAXED, __HIP_MEMORY_SCOPE_AGENT); }
__device__ __forceinline__ unsigned xb_xcc_id() { return (unsigned)__builtin_amdgcn_s_getreg((3 << 11) | 20) & 0xFu; }
#define XB_SPIN(cond, bar) do { unsigned _sp = 0; while (cond) { __builtin_amdgcn_s_sleep(1); \
    if ((++_sp & 255u) == 0u) { if (xb_ld(&(bar)[XB_TMO])) break; if (_sp > XB_SPIN_CAP) { atomicAdd(&(bar)[XB_TMO], 1u); break; } } } } while (0)

struct XcdBarrier {
    unsigned* bar; unsigned x;
    volatile LAS unsigned* st;
};

__device__ __forceinline__ XcdBarrier xcd_barrier_post(unsigned* bar, volatile LAS unsigned* st) {
    XcdBarrier b; b.bar = bar; b.x = xb_xcc_id(); b.st = st;
    if (threadIdx.x == 0) (void)xb_add(&bar[XB_XCNT(b.x)], 1u);
    return b;
}
__device__ __forceinline__ void xcd_barrier_complete(unsigned* bar, unsigned x, unsigned& nloc, unsigned& nx) {
    const unsigned G = gridDim.x * gridDim.y * gridDim.z;
    unsigned sum, cnt, mine, sp = 0u;
    for (;;) {
        sum = 0u; cnt = 0u; mine = 0u;
#pragma unroll
        for (unsigned j = 0; j < 16; ++j) { const unsigned c = xb_ld(&bar[XB_XCNT(j)]); sum += c; cnt += (c > 0u) ? 1u : 0u; mine = (j == x) ? c : mine; }
        if (sum == G) break;
        __builtin_amdgcn_s_sleep(1);
        if ((++sp & 255u) == 0u) { if (xb_ld(&bar[XB_TMO])) break; if (sp > XB_SPIN_CAP) { atomicAdd(&bar[XB_TMO], 1u); break; } }
    }
    nloc = mine > 0u ? mine : 1u; nx = cnt > 0u ? cnt : 1u;
}

__device__ __forceinline__ void xcd_barrier(const XcdBarrier& b) {
    asm volatile("s_waitcnt vmcnt(0)" ::: "memory");
    __syncthreads();
    if (threadIdx.x == 0) {
        unsigned* bar = b.bar;
        __builtin_amdgcn_s_waitcnt(0);
        unsigned nloc = b.st[0], nx = b.st[1];
        if (nloc == 0u) { xcd_barrier_complete(bar, b.x, nloc, nx); b.st[0] = nloc; b.st[1] = nx; }
        const unsigned old = xb_add(&bar[XB_XSUB(b.x)], 1u);
        const unsigned gen = old / nloc;
        if (old + 1u == (gen + 1u) * nloc) {
            __builtin_amdgcn_fence(__ATOMIC_RELEASE, "agent");
            asm volatile("s_waitcnt vmcnt(0)" ::: "memory");
            const unsigned og = xb_add(&bar[XB_TOP], 1u);
            const unsigned tg = og / nx;
            if (og + 1u == (tg + 1u) * nx) xb_add(&bar[XB_TOPGEN], 1u);
            else XB_SPIN(xb_ld(&bar[XB_TOPGEN]) == tg, bar);
            __builtin_amdgcn_fence(__ATOMIC_ACQUIRE, "agent");
            xb_add(&bar[XB_XGEN(b.x)], 1u);
            asm volatile("s_waitcnt vmcnt(0)" ::: "memory");
        } else {
            XB_SPIN(xb_ld(&bar[XB_XGEN(b.x)]) == gen, bar);
            __builtin_amdgcn_fence(__ATOMIC_ACQUIRE, "agent");
            asm volatile("s_waitcnt vmcnt(0)" ::: "memory");
        }
    }
    __syncthreads();
}

__global__ void __launch_bounds__(NTHR, 2) mega_fwd(Args a) {
    extern __shared__ __attribute__((aligned(16))) unsigned char lds_raw[];
    LAS unsigned char* lds = (LAS unsigned char*)lds_raw;
    cg::grid_group grid = cg::this_grid();
    const int G = gridDim.x, lo = a.ph_lo, hi = a.ph_hi;
    unsigned char* ws = a.ws;
#ifndef PH_DISABLE
#define PH_DISABLE 0
#endif
#define IN(k) (lo <= (k) && (k) < hi && !((PH_DISABLE >> (k)) & 1))
#define SEAM(k) do { if (IN(k) && IN((k) + 1)) xcd_barrier(bar); } while (0)
    { volatile LAS unsigned* st = (volatile LAS unsigned*)(lds + LDS_BYTES - 64);
      if (threadIdx.x < 2) st[threadIdx.x] = 0u;
      __syncthreads(); }
    XcdBarrier bar = xcd_barrier_post((unsigned*)(ws + WS_CTL) + (lo == 0 ? 0 : XCD_BAR_WORDS), (volatile LAS unsigned*)(lds + LDS_BYTES - 64));
    if (hi > 1000) grid.sync();
    if (IN(0)) { prologue(a, lds, G); }
    SEAM(0);
    if (IN(1)) {
        pg8::Gemm g{(const bf16_t*)(ws + WS_H), (const bf16_t*)(ws + WS_WC), TP, 4096, 1024, 1024}; pg8::StaticOrder S; S.init(TP, 4096, G, (int)blockIdx.x);
        Epi1 E{(bf16_t*)(ws + WS_U), (bf16_t*)(ws + WS_Z), (bf16_t*)(ws + WS_XQ), (bf16_t*)(ws + WS_XZ), a.out};
        pg8::gemm_phase<Epi1, pg8::StaticOrder, true, true>(lds, g, S, E);
    }
    SEAM(1);
    if (IN(2)) {
        unsigned* flag = (unsigned*)(ws + WS_CTL) + 7168;
        for (int e = blockIdx.x; e < 80; e += G) {
            if (e < 64) { pg8::Gemm g{(const bf16_t*)(ws + WS_H), (const bf16_t*)(ws + WS_WC), TT, 4096, 1024, 1024}; OneTile S{128 + (e >> 4), e & 15};
                Epi1 E{(bf16_t*)(ws + WS_U), (bf16_t*)(ws + WS_Z), (bf16_t*)(ws + WS_XQ), (bf16_t*)(ws + WS_XZ), a.out};
                pg8::gemm_phase<Epi1, OneTile, true, true>(lds, g, S, E); }
            else { pg8::Gemm g{(const bf16_t*)(ws + WS_MP), (const bf16_t*)(ws + WS_WM), 512, 2048, 1024, 1024}; OneTile S{(e - 64) >> 3, (e - 64) & 7};
                EpiM E{(bf16_t*)(ws + WS_MK), (bf16_t*)(ws + WS_MV), a.out};
                pg8::gemm_phase<EpiM, OneTile, true, true>(lds, g, S, E); }
            asm volatile("s_waitcnt vmcnt(0)" ::: "memory"); __syncthreads();
            if (threadIdx.x == 0) { __builtin_amdgcn_fence(__ATOMIC_RELEASE, "agent"); asm volatile("s_waitcnt vmcnt(0)" ::: "memory"); (void)xb_add(flag, 1u); }
        }
        { const int tid = threadIdx.x; f32x2 wk[31];
#pragma unroll
          for (int k = 0; k < 31; ++k) wk[k] = *(const f32x2*)(a.in[10] + k * DM + 2 * tid);
          const f32x2 cb = *(const f32x2*)(a.in[11] + 2 * tid), lg = *(const f32x2*)(a.in[12] + 2 * tid), lb = *(const f32x2*)(a.in[13] + 2 * tid);
          const int sfirst = G >= 96 ? G - 16 : 0;
#pragma unroll 1
          for (int pass = 0; pass < 2; ++pass) {
              if (pass == 1) {
                  if (threadIdx.x == 0) { unsigned sp = 0; while (xb_ld(flag) < 80u) { __builtin_amdgcn_s_sleep(2); if (++sp > (1u << 22)) break; }
                      __builtin_amdgcn_fence(__ATOMIC_ACQUIRE, "agent"); asm volatile("s_waitcnt vmcnt(0)" ::: "memory"); }
                  __syncthreads(); }
              const int lim = pass ? 16 : 256;
#pragma unroll 1
              for (int idx = (int)blockIdx.x - (pass ? sfirst : 0); idx >= 0 && idx < lim; idx += G)
                  conv_run(a, lds, pass != 0, pass ? idx : idx >> 7, pass ? 0 : (idx & 127) * 4, pass ? 2 : 4, wk, cb, lg, lb);
          }
        }
    }
    if (IN(3)) {
        if (G >= 96) { const int c = blockIdx.x;
            if (c < 80) memattn_unit(a, lds, 0, c);
            else for (int u = c; u < 576; u += G - 80) memattn_unit(a, lds, 0, u);
        } else for (int u = blockIdx.x; u < 576; u += G) memattn_unit(a, lds, 0, u);
    }
    SEAM(3);
    if (IN(4)) {
        { pg8::Gemm g{(const bf16_t*)(ws + WS_A2), (const bf16_t*)(ws + WS_WO), TP, 1024, 1536, 1536}; pg8::StaticOrder S; S.init(TP, 1024, G, (int)blockIdx.x);
          Epi2a E{a.in[0], (bf16_t*)(ws + WS_H), (float*)(ws + WS_PS)};
#ifndef NO_MAIN
          pg8::gemm_phase<Epi2a, pg8::StaticOrder, true, true>(lds, g, S, E);
#endif
        }
        { pg8::Gemm g{(const bf16_t*)(ws + WS_A2), (const bf16_t*)(ws + WS_WO), TT, 1024, 384, 1536}; SplitOrder S{(int)blockIdx.x};
          EpiPart E{(float*)(ws + WS_PART)};
#ifndef NO_TAIL
          pg8::gemm_phase<EpiPart, SplitOrder, true, true>(lds, g, S, E);
#endif
        }
    }
    do { if (IN(4) && IN(6)) xcd_barrier(bar); } while (0);
    if (IN(6)) {
        pg8::Gemm g{(const bf16_t*)(ws + WS_H), (const bf16_t*)(ws + WS_WA), TT, 3328, 1024, 1024}; Order3 S{G, (int)blockIdx.x};
        Epi3 E{(bf16_t*)(ws + WS_U), (bf16_t*)(ws + WS_K), (bf16_t*)(ws + WS_V), (bf16_t*)(ws + WS_Z), (bf16_t*)(ws + WS_XQ), (bf16_t*)(ws + WS_XZ), a.out, (const float*)(ws + WS_PS), G >= 192 ? (const LAS float*)(lds + 131072) : (const LAS float*)nullptr};
        {
            LAS float* rt = (LAS float*)(lds + 131072); const float* PSg = (const float*)(ws + WS_PS);
            for (int i = (int)(threadIdx.x >> 8); i < 8; i += 2) { pg8::Unit uu; if (!S.next(i, uu)) break;
                const f32x4* pp = (const f32x4*)(PSg + ((size_t)uu.pm * 256 + (threadIdx.x & 255)) * 16); const f32x4 p0 = pp[0], p1 = pp[1], p2 = pp[2], p3 = pp[3];
                const float ssum = ((p0[0] + p0[1]) + (p0[2] + p0[3])) + ((p1[0] + p1[1]) + (p1[2] + p1[3])) + ((p2[0] + p2[1]) + (p2[2] + p2[3])) + ((p3[0] + p3[1]) + (p3[2] + p3[3]));
                rt[i * 256 + (threadIdx.x & 255)] = 1.0f / sqrtf(ssum * (1.f / DM) + 1e-6f); }
            __syncthreads(); }
        pg8::gemm_phase<Epi3, Order3, true, true>(lds, g, S, E);
        {
        const int tid = threadIdx.x, lane = tid & 63, wave = __builtin_amdgcn_readfirstlane(tid >> 6);
        const int gw = blockIdx.x * 8 + wave, NGW = G * 8; bf16_t* XB = (bf16_t*)(ws + WS_H); float* PS = (float*)(ws + WS_PS);
        const float* PART = (const float*)(ws + WS_PART);
        for (int mm = TP + gw; mm < TT; mm += NGW) {
            const size_t ro = (size_t)(mm - TP) * DM;
            const f32x4* xr = (const f32x4*)(a.in[1] + ro) + lane; u32x2* o8 = (u32x2*)(XB + (size_t)mm * DM) + lane; float s = 0.f;
#pragma unroll
            for (int j = 0; j < 4; ++j) { f32x4 v = xr[64 * j];
#pragma unroll
                for (int ks = 0; ks < 4; ++ks) v += ((const f32x4*)(PART + (size_t)ks * TSMP * DM + ro) + lane)[64 * j];
                s += (v.x * v.x + v.y * v.y) + (v.z * v.z + v.w * v.w); u32x2 w; w.x = pk2(v.x, v.y); w.y = pk2(v.z, v.w); o8[64 * j] = w; }
            s = wave_sum(s);
            if (lane < 16) PS[(size_t)mm * 16 + lane] = lane == 0 ? s : 0.f;
        }
            }
    }
    SEAM(6);
    if (IN(7)) {
        unsigned* flag = (unsigned*)(ws + WS_CTL) + 7232;
        for (int e = blockIdx.x; e < 180; e += G) {
            pg8::Gemm g{(const bf16_t*)(ws + WS_H), (const bf16_t*)(ws + WS_WA), TT, 3328, 1024, 1024};
            OneTile S{e < 52 ? 128 + e / 13 : 96 + ((e - 52) >> 2), e < 52 ? e % 13 : 9 + ((e - 52) & 3)};
            Epi3 E{(bf16_t*)(ws + WS_U), (bf16_t*)(ws + WS_K), (bf16_t*)(ws + WS_V), (bf16_t*)(ws + WS_Z), (bf16_t*)(ws + WS_XQ), (bf16_t*)(ws + WS_XZ), a.out, (const float*)(ws + WS_PS), (const LAS float*)(lds + 131072)};
            { LAS float* rt = (LAS float*)(lds + 131072); const float* PSg = (const float*)(ws + WS_PS);
              if (threadIdx.x < 256) { const f32x4* pp = (const f32x4*)(PSg + ((size_t)S.pm * 256 + threadIdx.x) * 16); const f32x4 p0 = pp[0], p1 = pp[1], p2 = pp[2], p3 = pp[3];
                  const float ssum = ((p0[0] + p0[1]) + (p0[2] + p0[3])) + ((p1[0] + p1[1]) + (p1[2] + p1[3])) + ((p2[0] + p2[1]) + (p2[2] + p2[3])) + ((p3[0] + p3[1]) + (p3[2] + p3[3]));
                  rt[threadIdx.x] = 1.0f / sqrtf(ssum * (1.f / DM) + 1e-6f); }
              __syncthreads(); }
            pg8::gemm_phase<Epi3, OneTile, true, true>(lds, g, S, E);
            asm volatile("s_waitcnt vmcnt(0)" ::: "memory"); __syncthreads();
            if (threadIdx.x == 0) { __builtin_amdgcn_fence(__ATOMIC_RELEASE, "agent"); asm volatile("s_waitcnt vmcnt(0)" ::: "memory"); (void)xb_add(flag, 1u); }
        }
        const int sfirst = G >= 64 ? G - 32 : 0;
#pragma unroll 1
        for (int pass = 0; pass < 2; ++pass) {
            if (pass == 1) {
                if (threadIdx.x == 0) { unsigned sp = 0; while (xb_ld(flag) < 180u) { __builtin_amdgcn_s_sleep(2); if (++sp > (1u << 22)) break; }
                    __builtin_amdgcn_fence(__ATOMIC_ACQUIRE, "agent"); asm volatile("s_waitcnt vmcnt(0)" ::: "memory"); }
                __syncthreads(); }
            const int first = pass ? ((int)blockIdx.x >= sfirst ? 1024 + (int)blockIdx.x - sfirst : 1056) : (int)blockIdx.x;
            swa_phase(a, lds, first, G, pass ? 1056 : 1024);
        }
    }
    if (IN(8)) {
        const int c = blockIdx.x; const bool bal = G >= 224;
#pragma unroll 1
        for (int k = 0; ; ++k) { int u;
            if (!bal) u = c + k * G; else if (c < 180) u = k < 2 ? c + 180 * k : 576; else u = 360 + (c - 180) + k * (G - 180);
            if (u >= 576) break;
            memattn_unit(a, lds, 1, u); }
    }
    SEAM(8);
    if (IN(9)) {
        { pg8::Gemm g{(const bf16_t*)(ws + WS_A2), (const bf16_t*)(ws + WS_WO) + (size_t)1024 * 1536, TP, 1024, 1536, 1536}; pg8::StaticOrder S; S.init(TP, 1024, G, (int)blockIdx.x);
          Epi2 E{(const bf16_t*)(ws + WS_H), (bf16_t*)(ws + WS_U)};
          pg8::gemm_phase<Epi2, pg8::StaticOrder, true, true>(lds, g, S, E); }
        { pg8::Gemm g{(const bf16_t*)(ws + WS_A2), (const bf16_t*)(ws + WS_WO) + (size_t)1024 * 1536, TT, 1024, 384, 1536}; SplitOrder S{(int)blockIdx.x};
          EpiPart E{(float*)(ws + WS_PART)};
#ifndef NO_TAIL
          pg8::gemm_phase<EpiPart, SplitOrder, true, true>(lds, g, S, E);
#endif
        }
    }
    SEAM(9);
    if (IN(10)) {
        const int tid = threadIdx.x, lane = tid & 63, wave = __builtin_amdgcn_readfirstlane(tid >> 6);
        const int gw = blockIdx.x * 8 + wave, NGW = G * 8;
        { int m = gw;
          for (; m + 3 * NGW < TP; m += 4 * NGW) rms_rows_final<4>((const bf16_t*)(ws + WS_U), a.out, m, NGW, a.in[18], lane);
          for (; m < TP; m += NGW) rms_rows_final<1>((const bf16_t*)(ws + WS_U), a.out, m, NGW, a.in[18], lane);
          for (m = TP + gw; m < TT; m += NGW) rms_row_final((const bf16_t*)(ws + WS_H) + (size_t)m * DM, a.out + (size_t)m * DM, a.in[18], lane, (const float*)(ws + WS_PART) + (size_t)(m - TP) * DM); }
    }
#undef IN
#undef SEAM
}

#ifndef MK_ONE_LAUNCH
#define MK_ONE_LAUNCH 1
#endif
extern "C" void kernel_launch(void* const* d_in, const int* in_sizes, int n_in, void* d_out, int out_size, void* d_ws, size_t ws_size, hipStream_t stream) {
    static int grid = 0;
    if (grid == 0) {
        if (n_in != 19 || (size_t)out_size != O_TOTAL || ws_size < WS_END) { fprintf(stderr, "kernel_launch: unexpected shapes (n_in %d out %d ws %zu)\n", n_in, out_size, ws_size); grid = -1; return; }
        int dev = 0, cus = 0, per_cu = 0;
        (void)hipGetDevice(&dev); (void)hipDeviceGetAttribute(&cus, hipDeviceAttributeMultiprocessorCount, dev);
        if (hipFuncSetAttribute((const void*)mega_fwd, hipFuncAttributeMaxDynamicSharedMemorySize, LDS_BYTES) != hipSuccess) { fprintf(stderr, "kernel_launch: hipFuncSetAttribute failed\n"); grid = -1; return; }
        if (hipOccupancyMaxActiveBlocksPerMultiprocessor(&per_cu, (const void*)mega_fwd, NTHR, LDS_BYTES) != hipSuccess || per_cu < 1) { fprintf(stderr, "kernel_launch: occupancy query says %d\n", per_cu); per_cu = 1; }
        (void)hipGetLastError();
        grid = cus;
    }
    if (grid < 0) return;
    if (hipMemsetAsync((char*)d_ws + WS_CTL, 0, CTL_BYTES, stream) != hipSuccess) { fprintf(stderr, "kernel_launch: memset failed\n"); return; }
    Args a{};
    for (int i = 0; i < 19; ++i) a.in[i] = (const float*)d_in[i];
    a.out = (float*)d_out; a.ws = (unsigned char*)d_ws;
#if MK_ONE_LAUNCH
#ifdef PROBE_SPLIT
    { a.ph_lo = 0; a.ph_hi = PROBE_SPLIT + 1; void* args0[] = {&a};
      (void)hipLaunchCooperativeKernel((const void*)mega_fwd, dim3(grid), dim3(NTHR), args0, LDS_BYTES, stream);
      a.ph_lo = PROBE_SPLIT; }
#else
    a.ph_lo = 0;
#endif
    a.ph_hi = 11;
    void* args[] = {&a};
    hipError_t e = hipLaunchCooperativeKernel((const void*)mega_fwd, dim3(grid), dim3(NTHR), args, LDS_BYTES, stream);
    if (e != hipSuccess) fprintf(stderr, "kernel_launch: cooperative launch failed: %s (grid %d)\n", hipGetErrorString(e), grid);
#else
    for (int p = 0; p < 11; ++p) { a.ph_lo = p; a.ph_hi = p + 1; hipLaunchKernelGGL(mega_fwd, dim3(grid), dim3(NTHR), LDS_BYTES, stream, a); }
#endif
}
```
